# Optimizing an MI355X kernel written in HIP

```python
import math
import jax, jax.numpy as jnp
from jax import lax
import numpy as np

D_MODEL = 1024
BATCH = 8
SEQ = 4096
DEPTH = 2

GRID_W = 64
CTX_LEN = 256
N_MOD = 9
D_FF = 2816
ALPHA = (2 * DEPTH) ** 0.25
BETA = (8 * DEPTH) ** -0.25
EPS = 1e-6
A_HEADS = 6
A_KV_HEADS = 2
HEAD_DIM = 64
ROPE_THETA = 10000.0
Q_BLOCK = 128
HY_WIDTH = 256
HY_EMB = 33
HY_BANDS = (HY_EMB - 1) // 2
HY_ORDER = 64
HY_TARGET = 1e-2
HY_FAST = 0.3
HY_SLOW = 1.5
C_HEADS = 6
C_Q_LORA = 256
C_KV_LORA = 128
C_NOPE = 64
C_ROPE = 32
C_V = 64
A_WIDTH = A_HEADS * HEAD_DIM
C_WIDTH = C_HEADS * C_V
D_MIX = A_WIDTH + HY_WIDTH + C_WIDTH
A_COLS = (A_HEADS + 2 * A_KV_HEADS) * HEAD_DIM
B_COLS = 3 * HY_WIDTH
C_COLS = C_Q_LORA + C_KV_LORA + C_ROPE
P_IN = A_COLS + B_COLS + C_COLS

kernel_name = "hybrid_parallel_gqa_hyena_mla_block"


def layer_norm(x, g=None, b=None):
    xf = x.astype(jnp.float32)
    mu = jnp.mean(xf, -1, keepdims=True)
    var = jnp.mean(jnp.square(xf - mu), -1, keepdims=True)
    y = (xf - mu) * lax.rsqrt(var + EPS)
    if g is not None:
        y = y * g + b
    return y.astype(x.dtype)


def rms_norm(x, g):
    xf = x.astype(jnp.float32)
    y = xf * lax.rsqrt(jnp.mean(jnp.square(xf), -1, keepdims=True) + EPS) * g
    return y.astype(x.dtype)


def axial_rope(rows, rot_dim):
    row = jnp.repeat(jnp.arange(rows, dtype=jnp.float32), GRID_W)
    col = jnp.tile(jnp.arange(GRID_W, dtype=jnp.float32), rows)
    n_freq = rot_dim // 4
    inv = ROPE_THETA ** (-jnp.arange(n_freq, dtype=jnp.float32) / n_freq)
    ang = jnp.concatenate([row[:, None] * inv, col[:, None] * inv], -1)
    return jnp.cos(ang)[:, None, :], jnp.sin(ang)[:, None, :]


def apply_rope(x, cos, sin):
    xf = x.astype(jnp.float32)
    half = xf.shape[-1] // 2
    x1, x2 = xf[..., :half], xf[..., half:]
    return jnp.concatenate([x1 * cos - x2 * sin, x2 * cos + x1 * sin], -1).astype(x.dtype)


def block_attention(q, k, v, scale):
    b, n_q, n_heads, d = q.shape
    n_kv = k.shape[2]
    n_blk = n_q // Q_BLOCK
    qb = (q * scale).reshape(b, n_blk, Q_BLOCK, n_kv, n_heads // n_kv, d).transpose(1, 0, 2, 3, 4, 5)

    def one_block(q_blk):
        s = jnp.einsum('bqkgd,bskd->bkgqs', q_blk, k, preferred_element_type=jnp.float32)
        p = jax.nn.softmax(s, axis=-1).astype(v.dtype)
        return jnp.einsum('bkgqs,bske->bqkge', p, v)

    o = lax.map(one_block, qb)
    return o.transpose(1, 0, 2, 3, 4, 5).reshape(b, n_q, n_heads * v.shape[-1])


def gqa_qkv(pa, q_g, k_g, rope):
    b, n, _ = pa.shape
    q, k, v = jnp.split(pa, [A_WIDTH, A_WIDTH + A_KV_HEADS * HEAD_DIM], -1)
    q = rms_norm(q.reshape(b, n, A_HEADS, HEAD_DIM), q_g)
    k = rms_norm(k.reshape(b, n, A_KV_HEADS, HEAD_DIM), k_g)
    v = v.reshape(b, n, A_KV_HEADS, HEAD_DIM)
    if rope is not None:
        q = apply_rope(q, *rope)
        k = apply_rope(k, *rope)
    return q, k, v


def mla_qkv(pc, q_g, kv_g, w_uq, w_ukv, rope):
    b, n, _ = pc.shape
    c_q, c_kv, k_r = jnp.split(pc, [C_Q_LORA, C_Q_LORA + C_KV_LORA], -1)
    q = (rms_norm(c_q, q_g) @ w_uq).reshape(b, n, C_HEADS, C_NOPE + C_ROPE)
    kv = (rms_norm(c_kv, kv_g) @ w_ukv).reshape(b, n, C_HEADS, C_NOPE + C_V)
    q_nope, q_rope = q[..., :C_NOPE], q[..., C_NOPE:]
    k_nope, v = kv[..., :C_NOPE], kv[..., C_NOPE:]
    k_r = k_r[:, :, None, :]
    if rope is not None:
        q_rope = apply_rope(q_rope, *rope)
        k_r = apply_rope(k_r, *rope)
    q = jnp.concatenate([q_nope, q_rope], -1)
    k = jnp.concatenate([k_nope, jnp.broadcast_to(k_r, (b, n, C_HEADS, C_ROPE))], -1)
    return q, k, v


def hyena_filter(n, w1, b1, w2, b2, w3, b3, w4, freq):
    t = jnp.linspace(0.0, 1.0, n, dtype=jnp.float32)[:, None]
    w = 2.0 * math.pi * jnp.arange(n, dtype=jnp.float32)[:, None] / n
    f = jnp.linspace(1e-4, HY_BANDS - 1, HY_BANDS, dtype=jnp.float32)[None, :]
    z = jnp.concatenate([t, jnp.cos(f * w), -jnp.sin(f * w)], -1)
    hdn = jnp.sin(freq * (z @ w1 + b1))
    hdn = jnp.sin(freq * (hdn @ w2 + b2))
    hdn = jnp.sin(freq * (hdn @ w3 + b3))
    h = (hdn @ w4).astype(jnp.float32)
    deltas = jnp.abs(jnp.linspace(math.log(HY_TARGET) / HY_SLOW, math.log(HY_TARGET) / HY_FAST,
                                  HY_WIDTH, dtype=jnp.float32))
    h = h * jnp.exp(-t * jnp.tile(deltas, 2))
    h_fwd, h_bwd = h[:, :HY_WIDTH], h[:, HY_WIDTH:]
    filt = jnp.concatenate([h_fwd, jnp.zeros((1, HY_WIDTH), jnp.float32), h_bwd[:0:-1]], 0)
    return filt / jnp.sum(jnp.abs(filt), 0, keepdims=True)


def hyena_mix(p, conv_w, conv_b, w1, b1, w2, b2, w3, b3, w4, freq, d_skip):
    n = p.shape[1]
    pp = jnp.pad(p, ((0, 0), (1, 1), (0, 0)))
    p = pp[:, :-2] * conv_w[0] + pp[:, 1:-1] * conv_w[1] + pp[:, 2:] * conv_w[2] + conv_b
    v, x1, x0 = jnp.split(p, 3, -1)
    u = (v * x1).astype(jnp.float32)
    filt = hyena_filter(n, w1, b1, w2, b2, w3, b3, w4, freq)
    uf = jnp.fft.rfft(u, n=2 * n, axis=1)
    y = jnp.fft.irfft(uf * jnp.fft.rfft(filt, axis=0)[None], n=2 * n, axis=1)[:, :n]
    y = y + u * d_skip
    return (y * x0).astype(x0.dtype)


def modulate(x, shift, scale):
    return layer_norm(x) * (1.0 + scale) + shift


def swiglu(h, w_gu, w_down):
    g, u = jnp.split(h @ w_gu, 2, -1)
    return (jax.nn.silu(g) * u) @ w_down


def ffn_sublayer(x, m, w_gu, w_down, g, b):
    y = swiglu(modulate(x, m[:, 0], m[:, 1]), w_gu, w_down)
    return layer_norm(ALPHA * x + 0.5 * m[:, 2] * y, g, b)


def token_mix(h_lat, h_ctx, w_in, w_out, a_qn, a_kn, hy, mla, rope_a, rope_c, need_ctx):
    p_lat = h_lat @ w_in
    p_ctx = h_ctx @ w_in
    pa_l, pb_l, pc_l = jnp.split(p_lat, [A_COLS, A_COLS + B_COLS], -1)
    pa_c, pb_c, pc_c = jnp.split(p_ctx, [A_COLS, A_COLS + B_COLS], -1)
    qa_l, ka_l, va_l = gqa_qkv(pa_l, a_qn, a_kn, rope_a)
    qa_c, ka_c, va_c = gqa_qkv(pa_c, a_qn, a_kn, None)
    oa_l = block_attention(qa_l, jnp.concatenate([ka_c, ka_l], 1), jnp.concatenate([va_c, va_l], 1),
                           HEAD_DIM ** -0.5)
    qc_l, kc_l, vc_l = mla_qkv(pc_l, *mla, rope_c)
    qc_c, kc_c, vc_c = mla_qkv(pc_c, *mla, None)
    oc_l = block_attention(qc_l, jnp.concatenate([kc_c, kc_l], 1), jnp.concatenate([vc_c, vc_l], 1),
                           (C_NOPE + C_ROPE) ** -0.5)
    ob_l = hyena_mix(pb_l, *hy)
    out_lat = jnp.concatenate([oa_l, ob_l, oc_l], -1) @ w_out
    if not need_ctx:
        return out_lat, None
    oa_c = block_attention(qa_c, ka_c, va_c, HEAD_DIM ** -0.5)
    oc_c = block_attention(qc_c, kc_c, vc_c, (C_NOPE + C_ROPE) ** -0.5)
    ob_c = hyena_mix(pb_c, *hy)
    out_ctx = jnp.concatenate([oa_c, ob_c, oc_c], -1) @ w_out
    return out_lat, out_ctx


def setup_inputs(seed: int = 0) -> dict:
    key = jax.random.key(seed)
    keys = list(jax.random.split(key, 40))

    def nrm(i, shape, s):
        return jax.random.normal(keys[i], shape, jnp.float32) * s

    L = DEPTH
    return {
        "x": nrm(0, (BATCH, SEQ, D_MODEL), 1.0),
        "c": nrm(1, (BATCH, D_MODEL), 1.0),
        "ctx": nrm(2, (BATCH, CTX_LEN, D_MODEL), 1.0),
        "c_ctx": nrm(3, (D_MODEL,), 1.0),
        "ada_w": nrm(4, (L, D_MODEL, N_MOD * D_MODEL), 0.5 * D_MODEL ** -0.5),
        "ada_b": nrm(5, (L, N_MOD * D_MODEL), 0.01),
        "ffn1_w_gu": nrm(6, (L, D_MODEL, 2 * D_FF), D_MODEL ** -0.5),
        "ffn1_w_down": nrm(7, (L, D_FF, D_MODEL), BETA * D_FF ** -0.5),
        "ffn2_w_gu": nrm(8, (L, D_MODEL, 2 * D_FF), D_MODEL ** -0.5),
        "ffn2_w_down": nrm(9, (L, D_FF, D_MODEL), BETA * D_FF ** -0.5),
        "ln_g": 1.0 + nrm(10, (L, 3, D_MODEL), 0.01),
        "ln_b": nrm(11, (L, 3, D_MODEL), 0.01),
        "w_in": nrm(12, (L, D_MODEL, P_IN), D_MODEL ** -0.5),
        "w_out": nrm(13, (L, D_MIX, D_MODEL), BETA * D_MIX ** -0.5),
        "a_q_norm": 1.0 + nrm(14, (L, HEAD_DIM), 0.01),
        "a_k_norm": 1.0 + nrm(15, (L, HEAD_DIM), 0.01),
        "hy_conv_w": nrm(16, (L, 3, B_COLS), 3 ** -0.5),
        "hy_conv_b": nrm(17, (L, B_COLS), 0.01),
        "hy_f_w1": nrm(18, (L, HY_EMB, HY_ORDER), HY_EMB ** -0.5),
        "hy_f_b1": nrm(19, (L, HY_ORDER), 0.01),
        "hy_f_w2": nrm(20, (L, HY_ORDER, HY_ORDER), HY_ORDER ** -0.5),
        "hy_f_b2": nrm(21, (L, HY_ORDER), 0.01),
        "hy_f_w3": nrm(22, (L, HY_ORDER, HY_ORDER), HY_ORDER ** -0.5),
        "hy_f_b3": nrm(23, (L, HY_ORDER), 0.01),
        "hy_f_w4": nrm(24, (L, HY_ORDER, 2 * HY_WIDTH), HY_ORDER ** -0.5),
        "hy_f_freq": 1.0 + nrm(25, (L, HY_ORDER), 0.01),
        "hy_bias": nrm(26, (L, HY_WIDTH), 0.1),
        "mla_q_norm": 1.0 + nrm(27, (L, C_Q_LORA), 0.01),
        "mla_kv_norm": 1.0 + nrm(28, (L, C_KV_LORA), 0.01),
        "mla_w_uq": nrm(29, (L, C_Q_LORA, C_HEADS * (C_NOPE + C_ROPE)), C_Q_LORA ** -0.5),
        "mla_w_ukv": nrm(30, (L, C_KV_LORA, C_HEADS * (C_NOPE + C_V)), C_KV_LORA ** -0.5),
    }


def reference(x, c, ctx, c_ctx, ada_w, ada_b, ffn1_w_gu, ffn1_w_down, ffn2_w_gu, ffn2_w_down,
              ln_g, ln_b, w_in, w_out, a_q_norm, a_k_norm, hy_conv_w, hy_conv_b,
              hy_f_w1, hy_f_b1, hy_f_w2, hy_f_b2, hy_f_w3, hy_f_b3, hy_f_w4, hy_f_freq, hy_bias,
              mla_q_norm, mla_kv_norm, mla_w_uq, mla_w_ukv):
    b, n_lat, _ = x.shape
    rows = n_lat // GRID_W
    rope_a = axial_rope(rows, HEAD_DIM)
    rope_c = axial_rope(rows, C_ROPE)
    for l in range(DEPTH):
        need_ctx = l < DEPTH - 1
        m_lat = (jax.nn.silu(c) @ ada_w[l] + ada_b[l]).reshape(b, N_MOD, 1, D_MODEL)
        m_ctx = (jax.nn.silu(c_ctx) @ ada_w[l] + ada_b[l]).reshape(1, N_MOD, 1, D_MODEL)
        x = ffn_sublayer(x, m_lat[:, 0:3], ffn1_w_gu[l], ffn1_w_down[l], ln_g[l, 0], ln_b[l, 0])
        ctx = ffn_sublayer(ctx, m_ctx[:, 0:3], ffn1_w_gu[l], ffn1_w_down[l], ln_g[l, 0], ln_b[l, 0])
        hy = (hy_conv_w[l], hy_conv_b[l], hy_f_w1[l], hy_f_b1[l], hy_f_w2[l], hy_f_b2[l],
              hy_f_w3[l], hy_f_b3[l], hy_f_w4[l], hy_f_freq[l], hy_bias[l])
        mla = (mla_q_norm[l], mla_kv_norm[l], mla_w_uq[l], mla_w_ukv[l])
        mix_lat, mix_ctx = token_mix(modulate(x, m_lat[:, 3], m_lat[:, 4]),
                                     modulate(ctx, m_ctx[:, 3], m_ctx[:, 4]),
                                     w_in[l], w_out[l], a_q_norm[l], a_k_norm[l], hy, mla,
                                     rope_a, rope_c, need_ctx)
        x = layer_norm(ALPHA * x + m_lat[:, 5] * mix_lat, ln_g[l, 1], ln_b[l, 1])
        x = ffn_sublayer(x, m_lat[:, 6:9], ffn2_w_gu[l], ffn2_w_down[l], ln_g[l, 2], ln_b[l, 2])
        if need_ctx:
            ctx = layer_norm(ALPHA * ctx + m_ctx[:, 5] * mix_ctx, ln_g[l, 1], ln_b[l, 1])
            ctx = ffn_sublayer(ctx, m_ctx[:, 6:9], ffn2_w_gu[l], ffn2_w_down[l], ln_g[l, 2], ln_b[l, 2])
    return x
```

```cpp
#include <hip/hip_runtime.h>
#include <hip/hip_cooperative_groups.h>
#include <cstdio>
#include <cstdint>
namespace cg = cooperative_groups;

#define LAS __attribute__((address_space(3)))
#define DI __device__ __forceinline__
typedef unsigned short bf16_t;
typedef short bf16x8 __attribute__((ext_vector_type(8)));
typedef short s16x4 __attribute__((ext_vector_type(4)));
typedef float f32x2 __attribute__((ext_vector_type(2)));
typedef float f32x4 __attribute__((ext_vector_type(4)));
typedef float f32x16 __attribute__((ext_vector_type(16)));
typedef unsigned u32x2 __attribute__((ext_vector_type(2)));
typedef unsigned u32x4 __attribute__((ext_vector_type(4)));
typedef __bf16 bf2_t __attribute__((ext_vector_type(2)));

constexpr int D = 1024, NB = 8, SEQ = 4096, CTXL = 256, DFF = 2816;
constexpr int MLAT = NB * SEQ, MCTX = NB * CTXL, MTOT = MLAT + MCTX;
constexpr float EPS = 1e-6f, ALPHA = 1.41421356237309515f, LOG2E = 1.44269504088896341f;
constexpr int NTHR = 512;
constexpr int LDS_BYTES = 147456;

constexpr size_t SZ_X = (size_t)MTOT * D * 4;
constexpr size_t WO_GU1 = 0, WO_D1 = WO_GU1 + (size_t)5632 * 1024 * 2, WO_GU2 = WO_D1 + (size_t)1024 * 2816 * 2, WO_D2 = WO_GU2 + (size_t)5632 * 1024 * 2,
                 WO_IN = WO_D2 + (size_t)1024 * 2816 * 2, WO_OUT = WO_IN + (size_t)2048 * 1024 * 2, WO_UP = WO_OUT + (size_t)1024 * 1024 * 2, SZ_WL = WO_UP + (size_t)1536 * 384 * 2;
constexpr size_t OFF_X = 0;
constexpr size_t OFF_W = OFF_X + SZ_X;
constexpr size_t OFF_MOD = OFF_W + 2 * SZ_WL;
constexpr size_t OFF_KF = OFF_MOD + (size_t)2 * 9 * 9216 * 4;
constexpr size_t OFF_KFC = OFF_KF + (size_t)2 * 256 * 8192 * 2;
constexpr size_t OFF_PART = OFF_KFC + (size_t)2 * 256 * 512 * 2;
constexpr size_t OFF_PARTC = OFF_PART + (size_t)2 * 128 * 512 * 4;
constexpr size_t OFF_ROPE = OFF_PARTC + (size_t)2 * 8 * 512 * 4;
constexpr size_t OFF_R1 = OFF_ROPE + (size_t)4096 * 48 * 8;
constexpr size_t SZ_R1 = (size_t)MTOT * 1024 * 2;
constexpr size_t OFF_R2 = OFF_R1 + SZ_R1;
constexpr size_t SZ_R2 = (size_t)MTOT * DFF * 2;
constexpr size_t OFF_PA = OFF_R2;
constexpr size_t OFF_HYU = OFF_PA + (size_t)MTOT * 640 * 2;
constexpr size_t OFF_HYX = OFF_HYU + (size_t)MTOT * 256 * 2;
constexpr size_t OFF_KR = OFF_HYX + (size_t)MTOT * 256 * 2;
constexpr size_t OFF_PBB = OFF_KR + (size_t)MTOT * 32 * 2;
constexpr size_t OFF_PC = OFF_PBB + (size_t)MTOT * 768 * 2;
constexpr size_t OFF_UPB = OFF_PBB;
constexpr size_t WS_END = OFF_R2 + SZ_R2;
static_assert(OFF_PC + (size_t)MTOT * 416 * 2 <= WS_END, "R2 overflow");
static_assert(OFF_UPB + (size_t)MTOT * 1344 * 2 <= WS_END, "R2 overflow");
static_assert(WS_END <= (size_t)536870912, "workspace too large");

struct Params {
    const float* in[31];
    float* out;
    unsigned char* ws;
    int ph_lo, ph_hi;
};

DI float bf2f(bf16_t b) { return __uint_as_float(((unsigned)b) << 16); }
DI unsigned pack2(float a, float b) { f32x2 v = {a, b}; bf2_t r = __builtin_convertvector(v, bf2_t); return __builtin_bit_cast(unsigned, r); }
DI bf16_t f2bf(float a) { return (bf16_t)(pack2(a, 0.f) & 0xffffu); }
DI float wave_sum(float v) {
#pragma unroll
    for (int o = 32; o > 0; o >>= 1) v += __shfl_xor(v, o);
    return v;
}
DI float fast_exp2(float x) { return __builtin_amdgcn_exp2f(x); }
DI int otid() { int t = threadIdx.x; asm volatile("" : "+v"(t)); return t; }
DI int obid() { int t = blockIdx.x; asm volatile("" : "+s"(t)); return t; }
DI int crow(int reg, int h) { return (reg & 3) + 8 * (reg >> 2) + 4 * h; }
#define MFMA32(a, b, c) __builtin_amdgcn_mfma_f32_32x32x16_bf16((a), (b), (c), 0, 0, 0)

DI float conv_src(const Params& p, int l, int mat, int k, int n) {
    if (mat == 0 || mat == 2) {
        const float* s = (mat == 0 ? p.in[6] : p.in[8]) + (size_t)l * 1024 * 5632;
        const int G = n >> 5, w = n & 31, unit = G * 16 + (w & 15), col = (w >> 4) * 2816 + unit;
        return s[(size_t)k * 5632 + col];
    } else if (mat == 1 || mat == 3) {
        const float* s = (mat == 1 ? p.in[7] : p.in[9]) + (size_t)l * 2816 * 1024;
        return s[(size_t)k * 1024 + n];
    } else if (mat == 4) {
        return n < 1824 ? p.in[12][(size_t)l * 1024 * 1824 + (size_t)k * 1824 + n] : 0.f;
    } else if (mat == 5) {
        return p.in[13][(size_t)l * 1024 * 1024 + (size_t)k * 1024 + n];
    } else {
        if (n < 576) return k < 256 ? p.in[27][l * 256 + k] * p.in[29][(size_t)l * 256 * 576 + (size_t)k * 576 + n] : 0.f;
        if (n < 1344) return k >= 256 ? p.in[28][l * 128 + (k - 256)] * p.in[30][(size_t)l * 128 * 768 + (size_t)(k - 256) * 768 + (n - 576)] : 0.f;
        return 0.f;
    }
}

DI void conv_item(const Params& p, int it, LAS unsigned char* lds) {
    LAS float* tile = (LAS float*)lds;
    const int tid = otid();
    const int l = it / 5136; int r = it % 5136;
    int mat, K; size_t woff;
    if (r < 1408) { mat = 0; K = 1024; woff = WO_GU1; }
    else if (r < 2112) { r -= 1408; mat = 1; K = 2816; woff = WO_D1; }
    else if (r < 3520) { r -= 2112; mat = 2; K = 1024; woff = WO_GU2; }
    else if (r < 4224) { r -= 3520; mat = 3; K = 2816; woff = WO_D2; }
    else if (r < 4736) { r -= 4224; mat = 4; K = 1024; woff = WO_IN; }
    else if (r < 4992) { r -= 4736; mat = 5; K = 1024; woff = WO_OUT; }
    else { r -= 4992; mat = 6; K = 384; woff = WO_UP; }
    const int nK = K / 64, tn = r / nK, tk = r % nK, n0 = tn * 64, k0 = tk * 64;
    bf16_t* dst = (bf16_t*)(p.ws + OFF_W + (size_t)l * SZ_WL + woff);
    {
        const int kk = tid >> 6, nn = tid & 63;
#pragma unroll
        for (int ps = 0; ps < 8; ++ps) {
            const int kl = ps * 8 + kk;
            tile[kl * 65 + nn] = conv_src(p, l, mat, k0 + kl, n0 + nn);
        }
    }
    __syncthreads();
    {
        const int nl = tid >> 3, kc = (tid & 7) * 8;
        u32x4 o;
        o.x = pack2(tile[(kc + 0) * 65 + nl], tile[(kc + 1) * 65 + nl]);
        o.y = pack2(tile[(kc + 2) * 65 + nl], tile[(kc + 3) * 65 + nl]);
        o.z = pack2(tile[(kc + 4) * 65 + nl], tile[(kc + 5) * 65 + nl]);
        o.w = pack2(tile[(kc + 6) * 65 + nl], tile[(kc + 7) * 65 + nl]);
        *(u32x4*)(dst + (size_t)(n0 + nl) * K + k0 + kc) = o;
    }
}

DI void mod_item(const Params& p, int it, LAS unsigned char* lds) {
    LAS float* s = (LAS float*)lds;
    LAS float* red = s + 9 * 1024;
    const int tid = otid();
    const int l = it / 72, jb = it % 72, j0 = jb * 128;
    for (int idx = tid; idx < 9 * 1024; idx += NTHR) {
        const int r = idx >> 10, k = idx & 1023;
        const float v = r < 8 ? p.in[1][r * 1024 + k] : p.in[3][k];
        s[idx] = v / (1.f + __expf(-v));
    }
    __syncthreads();
    const int jc = tid & 127, kg = tid >> 7;
    const float* w = p.in[4] + (size_t)l * 1024 * 9216 + j0 + jc;
    float acc[9];
#pragma unroll
    for (int r = 0; r < 9; ++r) acc[r] = 0.f;
#pragma unroll 8
    for (int k = kg * 256; k < kg * 256 + 256; ++k) {
        const float wv = w[(size_t)k * 9216];
#pragma unroll
        for (int r = 0; r < 9; ++r) acc[r] += s[r * 1024 + k] * wv;
    }
#pragma unroll
    for (int r = 0; r < 9; ++r) red[(kg * 9 + r) * 128 + jc] = acc[r];
    __syncthreads();
    float* mod = (float*)(p.ws + OFF_MOD) + (size_t)l * 9 * 9216;
    for (int idx = tid; idx < 9 * 128; idx += NTHR) {
        const int r = idx >> 7, c = idx & 127;
        const float v = red[(0 * 9 + r) * 128 + c] + red[(1 * 9 + r) * 128 + c] + red[(2 * 9 + r) * 128 + c] + red[(3 * 9 + r) * 128 + c] + p.in[5][l * 9216 + j0 + c];
        mod[(size_t)r * 9216 + j0 + c] = v;
    }
}

DI void filt_item(const Params& p, int it, LAS unsigned char* lds) {
    const int tid = otid();
    const int l = it / 136; int r = it % 136;
    const int which = r < 128 ? 0 : 1; if (which) r -= 128;
    const int n = which ? 256 : 4096, t0 = r * 32;
    LAS float* z = (LAS float*)lds;
    LAS float* hA = z + 32 * 33;
    LAS float* hB = hA + 32 * 64;
    LAS bf16_t* ot = (LAS bf16_t*)(hB + 32 * 64);
    for (int idx = tid; idx < 32 * 33; idx += NTHR) {
        const int tt = idx / 33, e = idx % 33, ti = t0 + tt;
        float v;
        if (e == 0) v = (float)ti / (float)(n - 1);
        else {
            const int j = (e - 1) & 15;
            const float f = 1e-4f + (float)j * ((15.f - 1e-4f) / 15.f);
            const float w = 6.283185307179586f * (float)ti / (float)n;
            const float a = f * w;
            v = e <= 16 ? cosf(a) : -sinf(a);
        }
        z[idx] = v;
    }
    __syncthreads();
    const float* W1 = p.in[18] + l * 33 * 64; const float* B1 = p.in[19] + l * 64;
    const float* W2 = p.in[20] + l * 64 * 64; const float* B2 = p.in[21] + l * 64;
    const float* W3 = p.in[22] + l * 64 * 64; const float* B3 = p.in[23] + l * 64;
    const float* W4 = p.in[24] + l * 64 * 512; const float* FR = p.in[25] + l * 64;
#pragma unroll
    for (int q = 0; q < 4; ++q) {
        const int idx = tid + q * NTHR, tt = idx >> 6, j = idx & 63;
        float a = B1[j];
        for (int e = 0; e < 33; ++e) a += z[tt * 33 + e] * W1[e * 64 + j];
        hA[idx] = sinf(FR[j] * a);
    }
    __syncthreads();
#pragma unroll
    for (int q = 0; q < 4; ++q) {
        const int idx = tid + q * NTHR, tt = idx >> 6, j = idx & 63;
        float a = B2[j];
        for (int e = 0; e < 64; ++e) a += hA[tt * 64 + e] * W2[e * 64 + j];
        hB[idx] = sinf(FR[j] * a);
    }
    __syncthreads();
#pragma unroll
    for (int q = 0; q < 4; ++q) {
        const int idx = tid + q * NTHR, tt = idx >> 6, j = idx & 63;
        float a = B3[j];
        for (int e = 0; e < 64; ++e) a += hB[tt * 64 + e] * W3[e * 64 + j];
        hA[idx] = sinf(FR[j] * a);
    }
    __syncthreads();
    {
        const int col = tid, c = col & 255;
        const float a0 = -3.0701134573253942f, a1 = -15.350567286626972f;
        const float delta = fabsf(a0 + (float)c * ((a1 - a0) / 255.f));
        float part = 0.f;
        for (int tt = 0; tt < 32; ++tt) {
            float a = 0.f;
            for (int e = 0; e < 64; ++e) a += hA[tt * 64 + e] * W4[e * 512 + col];
            const int ti = t0 + tt;
            const float tl = (float)ti / (float)(n - 1);
            float v = a * __expf(-tl * delta);
            if (col >= 256 && ti == 0) v = 0.f;
            part += fabsf(v);
            ot[col * 32 + tt] = f2bf(v);
        }
        float* pp = which ? (float*)(p.ws + OFF_PARTC) + ((size_t)l * 8 + r) * 512 : (float*)(p.ws + OFF_PART) + ((size_t)l * 128 + r) * 512;
        pp[col] = part;
    }
    __syncthreads();
    bf16_t* kf = which ? (bf16_t*)(p.ws + OFF_KFC) + (size_t)l * 256 * 512 : (bf16_t*)(p.ws + OFF_KF) + (size_t)l * 256 * 8192;
    for (int idx = tid; idx < 512 * 32; idx += NTHR) {
        const int col = idx >> 5, tt = idx & 31, ti = t0 + tt, c = col & 255;
        const bf16_t v = ot[col * 32 + tt];
        if (col < 256) kf[(size_t)c * (2 * n) + n + ti] = v;
        else if (ti == 0) kf[(size_t)c * (2 * n)] = 0;
        else kf[(size_t)c * (2 * n) + n - ti] = v;
    }
}

DI void rope_item(const Params& p, int it) {
    const int e = it * NTHR + otid();
    const int pos = e / 48, a = e % 48;
    const int row = pos >> 6, col = pos & 63;
    float inv, coord;
    if (a < 32) { const int f = a & 15; inv = powf(10000.f, -(float)f / 16.f); coord = (float)(a < 16 ? row : col); }
    else { const int a2 = a - 32, f = a2 & 7; inv = powf(10000.f, -(float)f / 8.f); coord = (float)(a2 < 8 ? row : col); }
    const float ang = coord * inv;
    f32x2 cs = {cosf(ang), sinf(ang)};
    ((f32x2*)(p.ws + OFF_ROPE))[e] = cs;
}

DI void phase_p0a(const Params& p, LAS unsigned char* lds) {
    constexpr int NMODI = 144, NFILT = 272, NROPE = 384, NCONV = 2 * 5136;
    constexpr int TOTAL = NMODI + NFILT + NROPE + NCONV;
    for (int it = blockIdx.x; it < TOTAL; it += gridDim.x) {
        if (it < NMODI) mod_item(p, it, lds);
        else if (it < NMODI + NFILT) filt_item(p, it - NMODI, lds);
        else if (it < NMODI + NFILT + NROPE) rope_item(p, it - NMODI - NFILT);
        else conv_item(p, it - NMODI - NFILT - NROPE, lds);
        __syncthreads();
    }
}

DI void phase_ln(const Params& p, int M, bool first, const float* g, const float* bta, bool do_mod, int lmod, int i_shift, int i_scale, bool write_out) {
    const int tid_ = otid(); const int lane = tid_ & 63, wv = tid_ >> 6;
    float* X = (float*)(p.ws + OFF_X);
    bf16_t* H = (bf16_t*)(p.ws + OFF_R1);
    const float* mod = (const float*)(p.ws + OFF_MOD) + (size_t)lmod * 9 * 9216;
    for (int row = blockIdx.x * 8 + wv; row < M; row += gridDim.x * 8) {
        const float* src = first ? (row < MLAT ? p.in[0] + (size_t)row * D : p.in[2] + (size_t)(row - MLAT) * D) : X + (size_t)row * D;
        f32x4 v[4];
#pragma unroll
        for (int q = 0; q < 4; ++q) v[q] = *(const f32x4*)(src + q * 256 + lane * 4);
        if (!first) {
            float s = 0.f;
#pragma unroll
            for (int q = 0; q < 4; ++q) s += (v[q][0] + v[q][1]) + (v[q][2] + v[q][3]);
            const float mu = wave_sum(s) * (1.f / 1024.f);
            float ss = 0.f;
#pragma unroll
            for (int q = 0; q < 4; ++q) { const f32x4 d = v[q] - mu; ss += (d[0] * d[0] + d[1] * d[1]) + (d[2] * d[2] + d[3] * d[3]); }
            const float rstd = rsqrtf(wave_sum(ss) * (1.f / 1024.f) + EPS);
#pragma unroll
            for (int q = 0; q < 4; ++q) {
                const f32x4 gg = *(const f32x4*)(g + q * 256 + lane * 4), bb = *(const f32x4*)(bta + q * 256 + lane * 4);
                v[q] = (v[q] - mu) * rstd * gg + bb;
            }
        }
#pragma unroll
        for (int q = 0; q < 4; ++q) *(f32x4*)(X + (size_t)row * D + q * 256 + lane * 4) = v[q];
        if (write_out && row < MLAT) {
#pragma unroll
            for (int q = 0; q < 4; ++q) *(f32x4*)(p.out + (size_t)row * D + q * 256 + lane * 4) = v[q];
        }
        if (do_mod) {
            float s = 0.f;
#pragma unroll
            for (int q = 0; q < 4; ++q) s += (v[q][0] + v[q][1]) + (v[q][2] + v[q][3]);
            const float mu = wave_sum(s) * (1.f / 1024.f);
            float ss = 0.f;
#pragma unroll
            for (int q = 0; q < 4; ++q) { const f32x4 d = v[q] - mu; ss += (d[0] * d[0] + d[1] * d[1]) + (d[2] * d[2] + d[3] * d[3]); }
            const float rstd = rsqrtf(wave_sum(ss) * (1.f / 1024.f) + EPS);
            const int bi = row < MLAT ? (row >> 12) : 8;
            const float* sh = mod + (size_t)bi * 9216 + i_shift * 1024;
            const float* sc = mod + (size_t)bi * 9216 + i_scale * 1024;
#pragma unroll
            for (int q = 0; q < 4; ++q) {
                const f32x4 s4 = *(const f32x4*)(sc + q * 256 + lane * 4), h4 = *(const f32x4*)(sh + q * 256 + lane * 4);
                const f32x4 o = (v[q] - mu) * rstd * (1.f + s4) + h4;
                u32x2 w; w.x = pack2(o[0], o[1]); w.y = pack2(o[2], o[3]);
                *(u32x2*)(H + (size_t)row * D + q * 256 + lane * 4) = w;
            }
        }
    }
}

namespace gm {
constexpr int BM = 256, BK = 64, HALF = 128, HTB = HALF * BK * 2, NXCD = 8, WGM = 8;
DI int lds_byte(int r, int c) { const int st = (r >> 4) * 2 + (c >> 5), rr = r & 15, cc = c & 31, ob = rr * 64 + cc * 2; return st * 1024 + (ob ^ (((ob >> 9) & 1) << 5)); }
DI void stage_rc(int b, int& R, int& C) { const int st = b / 1024, sb = b % 1024, swz = sb ^ (((sb >> 9) & 1) << 5); R = (st >> 1) * 16 + swz / 64; C = (st & 1) * 32 + (swz % 64) / 2; }

struct EpiSwiglu {
    bf16_t* act;
    DI void operator()(const f32x4 (&acc)[2][2][4][2], int pm, int pn, int wr, int wc, int fr, int fq) const {
#pragma unroll
        for (int ai = 0; ai < 2; ++ai)
#pragma unroll
            for (int m = 0; m < 4; ++m) {
                const int row = pm * 256 + ai * 128 + wr * 64 + m * 16 + fr;
#pragma unroll
                for (int bj = 0; bj < 2; ++bj) {
                    const int unit0 = (pn * 256 + bj * 128 + wc * 32) / 2 + fq * 4;
                    const f32x4 gt = acc[ai][bj][m][0], up = acc[ai][bj][m][1];
                    float o[4];
#pragma unroll
                    for (int j = 0; j < 4; ++j) o[j] = gt[j] * __builtin_amdgcn_rcpf(1.f + __expf(-gt[j])) * up[j];
                    u32x2 w; w.x = pack2(o[0], o[1]); w.y = pack2(o[2], o[3]);
                    *(u32x2*)(act + (size_t)row * DFF + unit0) = w;
                }
            }
    }
};
struct EpiResid {
    float* X; const float* gate; float coef;
    DI void operator()(const f32x4 (&acc)[2][2][4][2], int pm, int pn, int wr, int wc, int fr, int fq) const {
#pragma unroll
        for (int ai = 0; ai < 2; ++ai)
#pragma unroll
            for (int m = 0; m < 4; ++m) {
                const int row = pm * 256 + ai * 128 + wr * 64 + m * 16 + fr;
                const int bi = row < MLAT ? (row >> 12) : 8;
#pragma unroll
                for (int bj = 0; bj < 2; ++bj)
#pragma unroll
                    for (int n = 0; n < 2; ++n) {
                        const int col = pn * 256 + bj * 128 + wc * 32 + n * 16 + fq * 4;
                        const f32x4 gv = *(const f32x4*)(gate + (size_t)bi * 9216 + col);
                        float* xp = X + (size_t)row * D + col;
                        const f32x4 xv = *(const f32x4*)xp;
                        *(f32x4*)xp = ALPHA * xv + coef * gv * acc[ai][bj][m][n];
                    }
            }
    }
};
struct EpiWin {
    bf16_t* pa; bf16_t* pbb; bf16_t* pc;
    DI void operator()(const f32x4 (&acc)[2][2][4][2], int pm, int pn, int wr, int wc, int fr, int fq) const {
#pragma unroll
        for (int ai = 0; ai < 2; ++ai)
#pragma unroll
            for (int m = 0; m < 4; ++m) {
                const int row = pm * 256 + ai * 128 + wr * 64 + m * 16 + fr;
#pragma unroll
                for (int bj = 0; bj < 2; ++bj)
#pragma unroll
                    for (int n = 0; n < 2; ++n) {
                        const int col = pn * 256 + bj * 128 + wc * 32 + n * 16 + fq * 4;
                        const f32x4 a = acc[ai][bj][m][n];
                        u32x2 w; w.x = pack2(a[0], a[1]); w.y = pack2(a[2], a[3]);
                        if (col < 640) *(u32x2*)(pa + (size_t)row * 640 + col) = w;
                        else if (col < 1408) *(u32x2*)(pbb + (size_t)row * 768 + (col - 640)) = w;
                        else if (col < 1824) *(u32x2*)(pc + (size_t)row * 416 + (col - 1408)) = w;
                    }
            }
    }
};
struct EpiUp {
    bf16_t* upb; float qscale;
    DI void operator()(const f32x4 (&acc)[2][2][4][2], int pm, int pn, int wr, int wc, int fr, int fq) const {
#pragma unroll
        for (int ai = 0; ai < 2; ++ai)
#pragma unroll
            for (int m = 0; m < 4; ++m) {
                const int row = pm * 256 + ai * 128 + wr * 64 + m * 16 + fr;
#pragma unroll
                for (int bj = 0; bj < 2; ++bj)
#pragma unroll
                    for (int n = 0; n < 2; ++n) {
                        const int col = pn * 256 + bj * 128 + wc * 32 + n * 16 + fq * 4;
                        if (col < 1344) {
                            const float sc = col < 576 ? qscale : 1.f;
                            const f32x4 a = acc[ai][bj][m][n] * sc;
                            u32x2 w; w.x = pack2(a[0], a[1]); w.y = pack2(a[2], a[3]);
                            *(u32x2*)(upb + (size_t)row * 1344 + col) = w;
                        }
                    }
            }
    }
};

#define G_SA(b, h) (((b) * 2 + (h)) * HTB)
#define G_SB(b, h) ((4 + (b) * 2 + (h)) * HTB)
#define G_STAGE(bufoff, gbase, voff) do { _Pragma("unroll") for (int _i = 0; _i < 2; ++_i) \
        __builtin_amdgcn_global_load_lds((const unsigned*)((const char*)(gbase) + (voff)[_i]), (LAS unsigned*)(lds + (bufoff) + ldsw + _i * 8192), 16, 0, 0); } while (0)
#define G_LDA(dst, b, h) do { _Pragma("unroll") for (int m = 0; m < 4; ++m) _Pragma("unroll") for (int k = 0; k < 2; ++k) dst[m][k] = *(const LAS bf16x8*)(lds + G_SA(b, h) + aoff + m * 2048 + k * 1024); } while (0)
#define G_LDB(dst, b, h) do { _Pragma("unroll") for (int n = 0; n < 2; ++n) _Pragma("unroll") for (int k = 0; k < 2; ++k) dst[n][k] = *(const LAS bf16x8*)(lds + G_SB(b, h) + boff + n * 2048 + k * 1024); } while (0)
#define G_MMA(ai, bj, At, Bt) do { __builtin_amdgcn_s_setprio(1); _Pragma("unroll") for (int m = 0; m < 4; ++m) _Pragma("unroll") for (int n = 0; n < 2; ++n) _Pragma("unroll") for (int k = 0; k < 2; ++k) \
        acc[ai][bj][m][n] = __builtin_amdgcn_mfma_f32_16x16x32_bf16(Bt[n][k], At[m][k], acc[ai][bj][m][n], 0, 0, 0); __builtin_amdgcn_s_setprio(0); } while (0)
#define G_WAIT_V(n) asm volatile("s_waitcnt vmcnt(" #n ")" ::: "memory")
#define G_WAIT_L(n) asm volatile("s_waitcnt lgkmcnt(" #n ")" ::: "memory")
#define G_BAR __builtin_amdgcn_s_barrier()
#define G_SCHED __builtin_amdgcn_sched_barrier(0)

template <class Epi>
DI void gemm_phase(LAS unsigned char* lds, const bf16_t* A, int lda, const bf16_t* Bt, int ldb, int M, int N, int K, const Epi& epi) {
    const int tid = otid(), wid = __builtin_amdgcn_readfirstlane(tid >> 6), lane = tid & 63, wr = wid >> 2, wc = wid & 3, fr = lane & 15, fq = lane >> 4;
    const int nt = K / BK, nM = M / BM, nN = N / BM, nwg = nM * nN;
    unsigned voffA[2], voffB[2];
#pragma unroll
    for (int i = 0; i < 2; ++i) { int R, C; stage_rc(tid * 16 + i * 8192, R, C); voffA[i] = (unsigned)(R * lda + C) * 2u; voffB[i] = (unsigned)(R * ldb + C) * 2u; }
    const unsigned ldsw = (unsigned)wid * 1024u;
    const int aoff = lds_byte(wr * 64 + fr, fq * 8), boff = lds_byte(wc * 32 + fr, fq * 8);
    for (int L = blockIdx.x; L < nwg; L += gridDim.x) {
        int wgid = L;
        { const int q = nwg / NXCD, r = nwg % NXCD, xcd = wgid % NXCD, off = wgid / NXCD; wgid = (xcd < r ? xcd * (q + 1) : r * (q + 1) + (xcd - r) * q) + off; }
        const int nig = WGM * nN, gid = wgid / nig, fm = gid * WGM, gsz = (nM - fm) < WGM ? (nM - fm) : WGM;
        const int pm = fm + ((wgid % nig) % gsz), pn = (wgid % nig) / gsz;
        const char* A0 = (const char*)(A + (size_t)pm * BM * lda);
        const char* A1 = A0 + (size_t)HALF * lda * 2;
        const char* B0p = (const char*)(Bt + (size_t)pn * BM * ldb);
        const char* B1p = B0p + (size_t)HALF * ldb * 2;
#define KT(ptr, kt) ((ptr) + (size_t)(kt) * (BK * 2))
        f32x4 acc[2][2][4][2];
#pragma unroll
        for (int a = 0; a < 2; ++a)
#pragma unroll
            for (int b = 0; b < 2; ++b)
#pragma unroll
                for (int m = 0; m < 4; ++m)
#pragma unroll
                    for (int n = 0; n < 2; ++n) acc[a][b][m][n] = (f32x4){0.f, 0.f, 0.f, 0.f};
        bf16x8 At[4][2], B0[2][2], B1[2][2];
        G_STAGE(G_SB(0, 0), KT(B0p, 0), voffB); G_STAGE(G_SA(0, 0), KT(A0, 0), voffA);
        G_STAGE(G_SB(0, 1), KT(B1p, 0), voffB); G_STAGE(G_SA(0, 1), KT(A1, 0), voffA);
        if (wr == 1) G_BAR;
        G_WAIT_V(4); G_BAR;
        G_STAGE(G_SB(1, 0), KT(B0p, 1), voffB); G_STAGE(G_SA(1, 0), KT(A0, 1), voffA); G_STAGE(G_SB(1, 1), KT(B1p, 1), voffB);
        G_WAIT_V(6); G_BAR;
        for (int t = 0; t < nt - 2; t += 2) {
            G_LDB(B0, 0, 0); G_SCHED; G_LDA(At, 0, 0); G_STAGE(G_SA(1, 1), KT(A1, t + 1), voffA);
            G_WAIT_L(8); G_BAR; G_WAIT_L(0); G_MMA(0, 0, At, B0); G_BAR; G_SCHED;
            G_LDB(B1, 0, 1); G_STAGE(G_SB(0, 0), KT(B0p, t + 2), voffB);
            G_BAR; G_WAIT_L(0); G_MMA(0, 1, At, B1); G_BAR;
            G_LDA(At, 0, 1); G_STAGE(G_SA(0, 0), KT(A0, t + 2), voffA);
            G_BAR; G_WAIT_L(0); G_MMA(1, 0, At, B0); G_BAR; G_SCHED;
            G_STAGE(G_SB(0, 1), KT(B1p, t + 2), voffB);
            G_WAIT_V(6); G_BAR; G_MMA(1, 1, At, B1); G_BAR;
            G_LDB(B0, 1, 0); G_SCHED; G_LDA(At, 1, 0); G_STAGE(G_SA(0, 1), KT(A1, t + 2), voffA);
            G_WAIT_L(8); G_BAR; G_WAIT_L(0); G_MMA(0, 0, At, B0); G_BAR; G_SCHED;
            G_LDB(B1, 1, 1); G_STAGE(G_SB(1, 0), KT(B0p, t + 3), voffB);
            G_BAR; G_WAIT_L(0); G_MMA(0, 1, At, B1); G_BAR;
            G_LDA(At, 1, 1); G_STAGE(G_SA(1, 0), KT(A0, t + 3), voffA);
            G_BAR; G_WAIT_L(0); G_MMA(1, 0, At, B0); G_BAR; G_SCHED;
            G_STAGE(G_SB(1, 1), KT(B1p, t + 3), voffB);
            G_WAIT_V(6); G_BAR; G_MMA(1, 1, At, B1); G_BAR;
        }
        { G_LDB(B0, 0, 0); G_LDA(At, 0, 0); G_STAGE(G_SA(1, 1), KT(A1, nt - 1), voffA);
          G_BAR; G_WAIT_L(0); G_MMA(0, 0, At, B0); G_BAR;
          G_LDB(B1, 0, 1); G_BAR; G_WAIT_L(0); G_MMA(0, 1, At, B1); G_BAR;
          G_LDA(At, 0, 1); G_WAIT_V(4); G_BAR; G_WAIT_L(0); G_MMA(1, 0, At, B0); G_MMA(1, 1, At, B1); G_BAR; }
        { G_LDB(B0, 1, 0); G_LDA(At, 1, 0); G_WAIT_V(2); G_BAR; G_WAIT_L(0); G_MMA(0, 0, At, B0); G_BAR;
          G_LDB(B1, 1, 1); G_WAIT_V(0); G_BAR; G_WAIT_L(0); G_MMA(0, 1, At, B1); G_BAR;
          G_LDA(At, 1, 1); G_BAR; G_WAIT_L(0); G_MMA(1, 0, At, B0); G_MMA(1, 1, At, B1); G_BAR; }
        if (wr == 0) G_BAR;
        epi(acc, pm, pn, wr, wc, fr, fq);
    }
    __syncthreads();
}
}


DI void phase_post(const Params& p, int l) {
    const int tid_ = otid(); const int lane = tid_ & 63, wv = tid_ >> 6;
    bf16_t* PA = (bf16_t*)(p.ws + OFF_PA);
    const bf16_t* PBB = (const bf16_t*)(p.ws + OFF_PBB);
    const bf16_t* PC = (const bf16_t*)(p.ws + OFF_PC);
    bf16_t* HYU = (bf16_t*)(p.ws + OFF_HYU);
    bf16_t* HYX = (bf16_t*)(p.ws + OFF_HYX);
    bf16_t* KR = (bf16_t*)(p.ws + OFF_KR);
    bf16_t* CN = (bf16_t*)(p.ws + OFF_R1);
    const f32x2* ROPE = (const f32x2*)(p.ws + OFF_ROPE);
    const float gq = p.in[14][l * 64 + lane], gk = p.in[15][l * 64 + lane];
    const float* cw = p.in[16] + (size_t)l * 3 * 768;
    const float* cb = p.in[17] + (size_t)l * 768;
    for (int tok = blockIdx.x * 8 + wv; tok < MTOT; tok += gridDim.x * 8) {
        const bool lat = tok < MLAT;
        const int t = lat ? (tok & 4095) : ((tok - MLAT) & 255);
        const int n = lat ? SEQ : CTXL;
        bf16_t* pa = PA + (size_t)tok * 640;
        f32x2 csA = {1.f, 0.f};
        if (lat) csA = ROPE[(size_t)t * 48 + (lane & 31)];
#pragma unroll
        for (int hh = 0; hh < 8; ++hh) {
            float v = bf2f(pa[hh * 64 + lane]);
            const float ss = wave_sum(v * v);
            v = v * rsqrtf(ss * (1.f / 64.f) + EPS) * (hh < 6 ? gq : gk);
            const float pr = __shfl_xor(v, 32);
            if (lat) v = lane < 32 ? v * csA[0] - pr * csA[1] : v * csA[0] + pr * csA[1];
            if (hh < 6) v *= 0.125f * LOG2E;
            pa[hh * 64 + lane] = f2bf(v);
        }
        {
            const bf16_t* r0 = PBB + (size_t)tok * 768;
#pragma unroll
            for (int q = 0; q < 4; ++q) {
                const int c = lane + 64 * q;
                float o[3];
#pragma unroll
                for (int g3 = 0; g3 < 3; ++g3) {
                    const int col = g3 * 256 + c;
                    const float pm1 = t > 0 ? bf2f(r0[col - 768]) : 0.f;
                    const float p0 = bf2f(r0[col]);
                    const float pp1 = t < n - 1 ? bf2f(r0[col + 768]) : 0.f;
                    o[g3] = cw[col] * pm1 + cw[768 + col] * p0 + cw[1536 + col] * pp1 + cb[col];
                }
                HYU[(size_t)tok * 256 + c] = f2bf(o[0] * o[1]);
                HYX[(size_t)tok * 256 + c] = f2bf(o[2]);
            }
        }
        {
            const bf16_t* pc = PC + (size_t)tok * 416;
            float v[4]; float ss = 0.f;
#pragma unroll
            for (int q = 0; q < 4; ++q) { v[q] = bf2f(pc[lane + 64 * q]); ss += v[q] * v[q]; }
            const float rq = rsqrtf(wave_sum(ss) * (1.f / 256.f) + EPS);
#pragma unroll
            for (int q = 0; q < 4; ++q) CN[(size_t)tok * 384 + lane + 64 * q] = f2bf(v[q] * rq);
            float u[2]; float s2 = 0.f;
#pragma unroll
            for (int q = 0; q < 2; ++q) { u[q] = bf2f(pc[256 + lane + 64 * q]); s2 += u[q] * u[q]; }
            const float rk = rsqrtf(wave_sum(s2) * (1.f / 128.f) + EPS);
#pragma unroll
            for (int q = 0; q < 2; ++q) CN[(size_t)tok * 384 + 256 + lane + 64 * q] = f2bf(u[q] * rk);
            float kr = bf2f(pc[384 + (lane & 31)]);
            const float pr = __shfl_xor(kr, 16);
            if (lat) {
                const f32x2 cs = ROPE[(size_t)t * 48 + 32 + (lane & 15)];
                kr = (lane & 16) ? kr * cs[0] + pr * cs[1] : kr * cs[0] - pr * cs[1];
            }
            if (lane < 32) KR[(size_t)tok * 32 + lane] = f2bf(kr);
        }
    }
}

template <int DQK>
DI void attn_item(LAS unsigned char* lds, const bf16_t* qbase, int q_ld, const bf16_t* kc, const bf16_t* kl, const bf16_t* vc, const bf16_t* vl, int kv_ld,
                  const bf16_t* krc, const bf16_t* krl, int ntiles, bf16_t* obase, const f32x2* rope) {
    constexpr int KS = DQK + 8, VS = 68, KBYTES = 64 * KS * 2, BUF = KBYTES + 64 * VS * 2, NKK = DQK / 16;
    const int tid = otid(), lane = tid & 63, w = tid >> 6, li = lane & 31, h = lane >> 5;
    bf16x8 qf[NKK];
    {
        const bf16_t* qrow = qbase + (size_t)(32 * w + li) * q_ld;
#pragma unroll
        for (int kk = 0; kk < NKK; ++kk) qf[kk] = *(const bf16x8*)(qrow + 16 * kk + 8 * h);
        if (DQK == 96 && rope != nullptr) {
            const f32x2* cs = rope + (size_t)(32 * w + li) * 48 + 8 * h;
            bf16x8 a = qf[NKK - 2], b = qf[NKK - 1];
#pragma unroll
            for (int j = 0; j < 8; ++j) {
                const float x1 = bf2f((bf16_t)a[j]), x2 = bf2f((bf16_t)b[j]);
                const f32x2 c = cs[j];
                a[j] = (short)f2bf(x1 * c[0] - x2 * c[1]);
                b[j] = (short)f2bf(x2 * c[0] + x1 * c[1]);
            }
            qf[NKK - 2] = a; qf[NKK - 1] = b;
        }
    }
    f32x16 ot[2];
#pragma unroll
    for (int i = 0; i < 16; ++i) { ot[0][i] = 0.f; ot[1][i] = 0.f; }
    float m_run = -INFINITY, l_run = 0.f;
    const int kkey = tid >> 3, kch = tid & 7;
    const int vkey = lane, vch = w;
    const int rkey = tid >> 2, rch = tid & 3;
    u32x4 kreg, vreg, rreg;
#define ATT_LOAD(j) do { const int s0 = (j) * 64; \
        const bf16_t* kb = s0 < CTXL ? kc + (size_t)s0 * kv_ld : kl + (size_t)(s0 - CTXL) * kv_ld; \
        const bf16_t* vb = s0 < CTXL ? vc + (size_t)s0 * kv_ld : vl + (size_t)(s0 - CTXL) * kv_ld; \
        kreg = *(const u32x4*)(kb + (size_t)kkey * kv_ld + 8 * kch); \
        vreg = *(const u32x4*)(vb + (size_t)vkey * kv_ld + 8 * vch); \
        if (DQK == 96 && tid < 256) { const bf16_t* rb = s0 < CTXL ? krc + (size_t)s0 * 32 : krl + (size_t)(s0 - CTXL) * 32; rreg = *(const u32x4*)(rb + rkey * 32 + 8 * rch); } } while (0)
#define ATT_STORE(bufi) do { LAS unsigned char* kb_ = lds + (bufi) * BUF; LAS bf16_t* vt_ = (LAS bf16_t*)(kb_ + KBYTES); \
        *(LAS u32x4*)(kb_ + (kkey * KS + 8 * kch) * 2) = kreg; \
        if (DQK == 96 && tid < 256) *(LAS u32x4*)(kb_ + (rkey * KS + 64 + 8 * rch) * 2) = rreg; \
        _Pragma("unroll") for (int e = 0; e < 4; ++e) { const unsigned wd = vreg[e]; vt_[(8 * vch + 2 * e) * VS + vkey] = (bf16_t)(wd & 0xffffu); vt_[(8 * vch + 2 * e + 1) * VS + vkey] = (bf16_t)(wd >> 16); } } while (0)
    ATT_LOAD(0);
    ATT_STORE(0);
    __syncthreads();
    for (int j = 0; j < ntiles; ++j) {
        if (j + 1 < ntiles) ATT_LOAD(j + 1);
        LAS unsigned char* kb = lds + (j & 1) * BUF;
        LAS unsigned char* vt = kb + KBYTES;
        f32x16 st[2];
#pragma unroll
        for (int kt = 0; kt < 2; ++kt) {
#pragma unroll
            for (int i = 0; i < 16; ++i) st[kt][i] = 0.f;
#pragma unroll
            for (int kk = 0; kk < NKK; ++kk) {
                const bf16x8 kf = *(const LAS bf16x8*)(kb + ((32 * kt + li) * KS + 16 * kk + 8 * h) * 2);
                st[kt] = MFMA32(kf, qf[kk], st[kt]);
            }
        }
        __builtin_amdgcn_sched_barrier(0);
        float mx = st[0][0];
#pragma unroll
        for (int i = 1; i < 16; ++i) mx = fmaxf(mx, st[0][i]);
#pragma unroll
        for (int i = 0; i < 16; ++i) mx = fmaxf(mx, st[1][i]);
        mx = fmaxf(mx, __shfl_xor(mx, 32));
        const float m_new = fmaxf(m_run, mx);
        const float alpha = fast_exp2(m_run - m_new);
        m_run = m_new;
        float rs = 0.f;
#pragma unroll
        for (int kt = 0; kt < 2; ++kt)
#pragma unroll
            for (int i = 0; i < 16; ++i) { const float pv = fast_exp2(st[kt][i] - m_new); st[kt][i] = pv; rs += pv; }
        l_run = l_run * alpha + rs;
#pragma unroll
        for (int i = 0; i < 16; ++i) { ot[0][i] *= alpha; ot[1][i] *= alpha; }
        __builtin_amdgcn_sched_barrier(0);
        bf16x8 pf[2][2];
#pragma unroll
        for (int kt = 0; kt < 2; ++kt)
#pragma unroll
            for (int s = 0; s < 2; ++s) {
                u32x4 pk;
                pk.x = pack2(st[kt][8 * s + 0], st[kt][8 * s + 1]); pk.y = pack2(st[kt][8 * s + 2], st[kt][8 * s + 3]);
                pk.z = pack2(st[kt][8 * s + 4], st[kt][8 * s + 5]); pk.w = pack2(st[kt][8 * s + 6], st[kt][8 * s + 7]);
                pf[kt][s] = __builtin_bit_cast(bf16x8, pk);
            }
#pragma unroll
        for (int vtile = 0; vtile < 2; ++vtile)
#pragma unroll
            for (int kt = 0; kt < 2; ++kt)
#pragma unroll
                for (int s = 0; s < 2; ++s) {
                    const LAS unsigned char* ap = vt + ((32 * vtile + li) * VS + 32 * kt + 16 * s + 4 * h) * 2;
                    const u32x2 lo = *(const LAS u32x2*)ap, hi = *(const LAS u32x2*)(ap + 16);
                    u32x4 vv; vv.x = lo.x; vv.y = lo.y; vv.z = hi.x; vv.w = hi.y;
                    ot[vtile] = MFMA32(__builtin_bit_cast(bf16x8, vv), pf[kt][s], ot[vtile]);
                }
        if (j + 1 < ntiles) ATT_STORE((j + 1) & 1);
        __syncthreads();
    }
#undef ATT_LOAD
#undef ATT_STORE
    const float lt = l_run + __shfl_xor(l_run, 32);
    const float inv = 1.f / lt;
    bf16_t* orow = obase + (size_t)(32 * w + li) * 1024;
#pragma unroll
    for (int vtile = 0; vtile < 2; ++vtile)
#pragma unroll
        for (int g4 = 0; g4 < 4; ++g4) {
            u32x2 o; o.x = pack2(ot[vtile][4 * g4 + 0] * inv, ot[vtile][4 * g4 + 1] * inv); o.y = pack2(ot[vtile][4 * g4 + 2] * inv, ot[vtile][4 * g4 + 3] * inv);
            *(u32x2*)(orow + 32 * vtile + 8 * g4 + 4 * h) = o;
        }
}

template <int NBLK>
DI void hyena_item(LAS unsigned char* lds, const bf16_t* kf, float inv_norm, float dskip, const bf16_t* hyu, const bf16_t* hyx, bf16_t* mix, int tok0) {
    constexpr int n = 64 * NBLK, CL = 2 * n + 32, NCT = NBLK >= 64 ? 2 : 1;
    const int tid = otid(), lane = tid & 63, w = tid >> 6, li = lane & 31, h = lane >> 5;
    LAS bf16_t* cp = (LAS bf16_t*)lds;
    LAS bf16_t* U = cp + 4 * CL;
#pragma unroll 1
    for (int r = 0; r < 4; ++r) {
#pragma unroll 2
        for (int idx = tid; idx < CL; idx += NTHR) {
            const int y = idx - 4 + r;
            cp[r * CL + idx] = (y >= 0 && y < 2 * n) ? kf[2 * n - 1 - y] : (bf16_t)0;
        }
    }
    {
        const bf16_t* hb = hyu + (size_t)tok0 * 256;
#pragma unroll 4
        for (int idx = tid; idx < 8 * n; idx += NTHR) {
            const int b = idx / n, s = idx % n;
            U[(b * NBLK + (s >> 6)) * 72 + (s & 63)] = hb[(unsigned)idx * 256u];
        }
    }
    __syncthreads();
    f32x16 acc[2][NCT];
#pragma unroll
    for (int mt = 0; mt < 2; ++mt)
#pragma unroll
        for (int ct = 0; ct < NCT; ++ct)
#pragma unroll
            for (int i = 0; i < 16; ++i) acc[mt][ct][i] = 0.f;
    const LAS bf16_t* Uw = U + (size_t)w * NBLK * 72;
#pragma unroll 1
    for (int d = -(NBLK - 1); d <= NBLK - 1; ++d) {
        bool act[NCT]; int blk[NCT]; bool val[NCT];
#pragma unroll
        for (int ct = 0; ct < NCT; ++ct) {
            act[ct] = (32 * ct + 31 - d >= 0) && (32 * ct - d <= NBLK - 1);
            const int a = 32 * ct + li; blk[ct] = a - d; val[ct] = (blk[ct] >= 0) && (blk[ct] < NBLK) && (a < NBLK);
        }
#pragma unroll
        for (int ks = 0; ks < 4; ++ks) {
            bf16x8 af[2];
#pragma unroll
            for (int mt = 0; mt < 2; ++mt) {
                const int y0 = n - 1 - 64 * d - (32 * mt + li) + 16 * ks + 8 * h;
                const int r = y0 & 3, m0 = y0 - r + 4;
                const LAS bf16_t* ap = cp + r * CL + m0;
                const u32x2 lo = *(const LAS u32x2*)ap, hi = *(const LAS u32x2*)(ap + 4);
                u32x4 vv; vv.x = lo.x; vv.y = lo.y; vv.z = hi.x; vv.w = hi.y;
                af[mt] = __builtin_bit_cast(bf16x8, vv);
            }
#pragma unroll
            for (int ct = 0; ct < NCT; ++ct) {
                if (act[ct]) {
                    u32x4 bv = {0u, 0u, 0u, 0u};
                    if (val[ct]) bv = *(const LAS u32x4*)(Uw + blk[ct] * 72 + 16 * ks + 8 * h);
                    const bf16x8 bfv = __builtin_bit_cast(bf16x8, bv);
                    acc[0][ct] = MFMA32(af[0], bfv, acc[0][ct]);
                    acc[1][ct] = MFMA32(af[1], bfv, acc[1][ct]);
                }
            }
        }
    }
#pragma unroll
    for (int mt = 0; mt < 2; ++mt)
#pragma unroll
        for (int ct = 0; ct < NCT; ++ct) {
            const int a = 32 * ct + li;
            if (a < NBLK) {
                unsigned tokb = (unsigned)(tok0 + w * n + 64 * a + 32 * mt + 4 * h);
                asm volatile("" : "+v"(tokb));
                const LAS bf16_t* up = Uw + a * 72 + 32 * mt + 4 * h;
#pragma unroll
                for (int i = 0; i < 16; ++i) {
                    const unsigned tok = tokb + (unsigned)((i & 3) + 8 * (i >> 2));
                    const float uu = bf2f(up[(i & 3) + 8 * (i >> 2)]);
                    const float y = acc[mt][ct][i] * inv_norm + uu * dskip;
                    mix[tok * 1024u] = f2bf(y * bf2f(hyx[tok * 256u]));
                }
            }
            __builtin_amdgcn_sched_barrier(0);
        }
}

DI void phase_mix(const Params& p, int l, bool need_ctx, LAS unsigned char* lds) {
    const bf16_t* PA = (const bf16_t*)(p.ws + OFF_PA);
    const bf16_t* UPB = (const bf16_t*)(p.ws + OFF_UPB);
    const bf16_t* KR = (const bf16_t*)(p.ws + OFF_KR);
    const bf16_t* HYU = (const bf16_t*)(p.ws + OFF_HYU);
    const bf16_t* HYX = (const bf16_t*)(p.ws + OFF_HYX);
    bf16_t* MIX = (bf16_t*)(p.ws + OFF_R1);
    const f32x2* ROPE = (const f32x2*)(p.ws + OFF_ROPE);
    const int n_items = 256 + 768 + 768 + (need_ctx ? 48 + 48 + 256 : 0);
    LAS float* red = (LAS float*)lds;
    for (int it = blockIdx.x; it < n_items; it += gridDim.x) {
#ifndef MIXSEL
#define MIXSEL 0
#endif
        if ((MIXSEL == 0 || MIXSEL == 1) && (it < 256 || it >= 1888)) {
            const bool isl = it < 256;
            const int c = isl ? it : it - 1888;
            const float* part = isl ? (const float*)(p.ws + OFF_PART) + (size_t)l * 128 * 512 : (const float*)(p.ws + OFF_PARTC) + (size_t)l * 8 * 512;
            const int np = isl ? 128 : 8;
            float s = 0.f;
            if ((int)threadIdx.x < 2 * np) { const int r = threadIdx.x >> 1, hb = threadIdx.x & 1; s = part[(size_t)r * 512 + hb * 256 + c]; }
            s = wave_sum(s);
            __syncthreads();
            if ((threadIdx.x & 63) == 0) red[threadIdx.x >> 6] = s;
            __syncthreads();
            float nrm = 0.f;
#pragma unroll
            for (int i = 0; i < 8; ++i) nrm += red[i];
            __syncthreads();
            const float inv_norm = 1.f / nrm, dskip = p.in[26][l * 256 + c];
            if (isl) hyena_item<64>(lds, (const bf16_t*)(p.ws + OFF_KF) + ((size_t)l * 256 + c) * 8192, inv_norm, dskip, HYU + c, HYX + c, MIX + 384 + c, 0);
            else hyena_item<4>(lds, (const bf16_t*)(p.ws + OFF_KFC) + ((size_t)l * 256 + c) * 512, inv_norm, dskip, HYU + c, HYX + c, MIX + 384 + c, MLAT);
        } else if ((MIXSEL == 0 || MIXSEL == 2) && it < 1024) {
            const int idx = it - 256, qb = idx & 15, hd = (idx >> 4) % 6, b = idx / 96, hk = hd / 3;
            const size_t tl = (size_t)b * SEQ, tc = (size_t)MLAT + (size_t)b * CTXL;
            attn_item<64>(lds, PA + (tl + qb * 256) * 640 + hd * 64, 640, PA + tc * 640 + 384 + hk * 64, PA + tl * 640 + 384 + hk * 64,
                          PA + tc * 640 + 512 + hk * 64, PA + tl * 640 + 512 + hk * 64, 640, nullptr, nullptr, 68, MIX + (tl + qb * 256) * 1024 + hd * 64, nullptr);
        } else if ((MIXSEL == 0 || MIXSEL == 3) && it < 1792) {
            const int idx = it - 1024, qb = idx & 15, hd = (idx >> 4) % 6, b = idx / 96;
            const size_t tl = (size_t)b * SEQ, tc = (size_t)MLAT + (size_t)b * CTXL;
            attn_item<96>(lds, UPB + (tl + qb * 256) * 1344 + hd * 96, 1344, UPB + tc * 1344 + 576 + hd * 128, UPB + tl * 1344 + 576 + hd * 128,
                          UPB + tc * 1344 + 576 + hd * 128 + 64, UPB + tl * 1344 + 576 + hd * 128 + 64, 1344, KR + tc * 32, KR + tl * 32, 68,
                          MIX + (tl + qb * 256) * 1024 + 640 + hd * 64, ROPE + (size_t)(qb * 256) * 48 + 32);
        } else if ((MIXSEL == 0 || MIXSEL == 2) && it < 1840) {
            const int idx = it - 1792, hd = idx % 6, b = idx / 6, hk = hd / 3;
            const size_t tc = (size_t)MLAT + (size_t)b * CTXL;
            attn_item<64>(lds, PA + tc * 640 + hd * 64, 640, PA + tc * 640 + 384 + hk * 64, PA + tc * 640 + 384 + hk * 64,
                          PA + tc * 640 + 512 + hk * 64, PA + tc * 640 + 512 + hk * 64, 640, nullptr, nullptr, 4, MIX + tc * 1024 + hd * 64, nullptr);
        } else if (MIXSEL == 0 || MIXSEL == 3) {
            const int idx = it - 1840, hd = idx % 6, b = idx / 6;
            const size_t tc = (size_t)MLAT + (size_t)b * CTXL;
            attn_item<96>(lds, UPB + tc * 1344 + hd * 96, 1344, UPB + tc * 1344 + 576 + hd * 128, UPB + tc * 1344 + 576 + hd * 128,
                          UPB + tc * 1344 + 576 + hd * 128 + 64, UPB + tc * 1344 + 576 + hd * 128 + 64, 1344, KR + tc * 32, KR + tc * 32, 4,
                          MIX + tc * 1024 + 640 + hd * 64, nullptr);
        }
        __syncthreads();
    }
}

__global__ void __launch_bounds__(NTHR) mega(Params p) {
    extern __shared__ __attribute__((aligned(16))) unsigned char lds_raw[];
    LAS unsigned char* lds = (LAS unsigned char*)lds_raw;
    cg::grid_group grid = cg::this_grid();
    int ph = 0;
#ifndef ONLY
#define ONLY -1
#endif
#define PHASE(kind, body) do { if ((ONLY < 0 || ONLY == (kind)) && ph >= p.ph_lo && ph < p.ph_hi) { body; if (ph + 1 < p.ph_hi) grid.sync(); } ++ph; } while (0)
    unsigned char* ws = p.ws;
    float* X = (float*)(ws + OFF_X);
    bf16_t* H = (bf16_t*)(ws + OFF_R1);
    bf16_t* ACT = (bf16_t*)(ws + OFF_R2);
    PHASE(0, phase_p0a(p, lds));
    PHASE(1, phase_ln(p, MTOT, true, nullptr, nullptr, true, 0, 0, 1, false));
#pragma unroll 1
    for (int l = 0; l < 2; ++l) {
        const unsigned char* W = ws + OFF_W + (size_t)l * SZ_WL;
        const float* mod = (const float*)(ws + OFF_MOD) + (size_t)l * 9 * 9216;
#pragma unroll 1
        for (int s = 0; s < 3; ++s) {
            const int Mrows = (l == 1 && s == 2) ? MLAT : MTOT;
            if (s != 1) {
                const bf16_t* wgu = (const bf16_t*)(W + (s == 0 ? WO_GU1 : WO_GU2));
                const bf16_t* wd = (const bf16_t*)(W + (s == 0 ? WO_D1 : WO_D2));
                PHASE(2, gm::gemm_phase(lds, H, 1024, wgu, 1024, Mrows, 5632, 1024, gm::EpiSwiglu{ACT}));
                PHASE(3, gm::gemm_phase(lds, ACT, DFF, wd, DFF, Mrows, 1024, DFF, gm::EpiResid{X, mod + (s == 0 ? 2 : 8) * 1024, 0.5f}));
                const bool last = (l == 1 && s == 2);
                const bool dm = !last;
                const int lm = (s == 0) ? l : l + 1;
                PHASE(1, phase_ln(p, Mrows, false, p.in[10] + (size_t)(l * 3 + s) * D, p.in[11] + (size_t)(l * 3 + s) * D, dm, dm ? lm : 0, s == 0 ? 3 : 0, s == 0 ? 4 : 1, last));
            } else {
                PHASE(4, gm::gemm_phase(lds, H, 1024, (const bf16_t*)(W + WO_IN), 1024, MTOT, 2048, 1024,
                                     gm::EpiWin{(bf16_t*)(ws + OFF_PA), (bf16_t*)(ws + OFF_PBB), (bf16_t*)(ws + OFF_PC)}));
                PHASE(5, phase_post(p, l));
                PHASE(6, gm::gemm_phase(lds, (const bf16_t*)(ws + OFF_R1), 384, (const bf16_t*)(W + WO_UP), 384, MTOT, 1536, 384,
                                     gm::EpiUp{(bf16_t*)(ws + OFF_UPB), 0.10206207261596577f * LOG2E}));
                PHASE(7, phase_mix(p, l, l == 0, lds));
                const int Mo = (l == 1) ? MLAT : MTOT;
                PHASE(8, gm::gemm_phase(lds, (const bf16_t*)(ws + OFF_R1), 1024, (const bf16_t*)(W + WO_OUT), 1024, Mo, 1024, 1024, gm::EpiResid{X, mod + 5 * 1024, 1.0f}));
                PHASE(1, phase_ln(p, Mo, false, p.in[10] + (size_t)(l * 3 + 1) * D, p.in[11] + (size_t)(l * 3 + 1) * D, true, l, 6, 7, false));
            }
        }
    }
}

constexpr int NPHASES = 2 + 2 * 12;

extern "C" void kernel_launch(void* const* d_in, const int* in_sizes, int n_in, void* d_out, int out_size, void* d_ws, size_t ws_size, hipStream_t stream) {
    static int grid = 0;
    if (grid == 0) {
        if (n_in != 31 || ws_size < WS_END) { fprintf(stderr, "kernel_launch: unexpected n_in %d or ws_size %zu (< %zu)\n", n_in, ws_size, (size_t)WS_END); grid = -1; return; }
        int dev = 0, cus = 0, per_cu = 0;
        hipGetDevice(&dev);
        hipDeviceGetAttribute(&cus, hipDeviceAttributeMultiprocessorCount, dev);
        if (hipFuncSetAttribute((const void*)mega, hipFuncAttributeMaxDynamicSharedMemorySize, LDS_BYTES) != hipSuccess) { fprintf(stderr, "kernel_launch: hipFuncSetAttribute failed\n"); grid = -1; return; }
        if (hipOccupancyMaxActiveBlocksPerMultiprocessor(&per_cu, (const void*)mega, NTHR, LDS_BYTES) != hipSuccess || per_cu < 1) { fprintf(stderr, "kernel_launch: occupancy query failed (%d)\n", per_cu); per_cu = 1; }
        (void)hipGetLastError();
        grid = cus * (per_cu > 1 ? 1 : per_cu);
    }
    if (grid < 0) return;
    Params prm{};
    for (int i = 0; i < 31; ++i) prm.in[i] = (const float*)d_in[i];
    prm.out = (float*)d_out; prm.ws = (unsigned char*)d_ws;
    prm.ph_lo = 0; prm.ph_hi = NPHASES;
    void* args[] = {&prm};
    hipError_t e = hipLaunchCooperativeKernel((const void*)mega, dim3(grid), dim3(NTHR), args, LDS_BYTES, stream);
    if (e != hipSuccess) fprintf(stderr, "kernel_launch: cooperative launch failed: %s (grid %d)\n", hipGetErrorString(e), grid);
}
```

```cpp
#include <hip/hip_runtime.h>
#include <hip/hip_cooperative_groups.h>
#include <cstdio>
#include <cstdint>
namespace cg = cooperative_groups;

#define LAS __attribute__((address_space(3)))
#define DI __device__ __forceinline__
typedef unsigned short bf16_t;
typedef short bf16x8 __attribute__((ext_vector_type(8)));
typedef short s16x4 __attribute__((ext_vector_type(4)));
typedef float f32x2 __attribute__((ext_vector_type(2)));
typedef float f32x4 __attribute__((ext_vector_type(4)));
typedef float f32x16 __attribute__((ext_vector_type(16)));
typedef unsigned u32x2 __attribute__((ext_vector_type(2)));
typedef unsigned u32x4 __attribute__((ext_vector_type(4)));
typedef __bf16 bf2_t __attribute__((ext_vector_type(2)));

constexpr int D = 1024, NB = 8, SEQ = 4096, CTXL = 256, DFF = 2816;
constexpr int MLAT = NB * SEQ, MCTX = NB * CTXL, MTOT = MLAT + MCTX;
constexpr float EPS = 1e-6f, ALPHA = 1.41421356237309515f, LOG2E = 1.44269504088896341f;
constexpr int NTHR = 512;
constexpr int LDS_BYTES = 147456;

constexpr size_t SZ_X = (size_t)MTOT * D * 4;
constexpr size_t WO_GU1 = 0, WO_D1 = WO_GU1 + (size_t)5632 * 1024 * 2, WO_GU2 = WO_D1 + (size_t)1024 * 2816 * 2, WO_D2 = WO_GU2 + (size_t)5632 * 1024 * 2,
                 WO_IN = WO_D2 + (size_t)1024 * 2816 * 2, WO_OUT = WO_IN + (size_t)2048 * 1024 * 2, WO_UP = WO_OUT + (size_t)1024 * 1024 * 2, SZ_WL = WO_UP + (size_t)1536 * 384 * 2;
constexpr size_t OFF_X = 0;
constexpr size_t OFF_W = OFF_X + SZ_X;
constexpr size_t OFF_MOD = OFF_W + 2 * SZ_WL;
constexpr size_t OFF_KF = OFF_MOD + (size_t)2 * 9 * 9216 * 4;
constexpr size_t OFF_KFC = OFF_KF + (size_t)2 * 256 * 8192 * 2;
constexpr size_t OFF_PART = OFF_KFC + (size_t)2 * 256 * 512 * 2;
constexpr size_t OFF_PARTC = OFF_PART + (size_t)2 * 128 * 512 * 4;
constexpr size_t OFF_ROPE = OFF_PARTC + (size_t)2 * 8 * 512 * 4;
constexpr size_t OFF_R1 = OFF_ROPE + (size_t)4096 * 48 * 8;
constexpr size_t SZ_R1 = (size_t)MTOT * 1024 * 2;
constexpr size_t OFF_R2 = OFF_R1 + SZ_R1;
constexpr size_t SZ_R2 = (size_t)MTOT * DFF * 2;
constexpr size_t OFF_PA = OFF_R2;
constexpr size_t OFF_HYU = OFF_PA + (size_t)MTOT * 640 * 2;
constexpr size_t OFF_HYX = OFF_HYU + (size_t)MTOT * 256 * 2;
constexpr size_t OFF_KR = OFF_HYX + (size_t)MTOT * 256 * 2;
constexpr size_t OFF_PBB = OFF_KR + (size_t)MTOT * 32 * 2;
constexpr size_t OFF_PC = OFF_PBB + (size_t)MTOT * 768 * 2;
constexpr size_t OFF_UPB = OFF_PBB;
constexpr size_t OFF_OBT = OFF_UPB + (size_t)MTOT * 1344 * 2;
constexpr size_t OFF_BAR = OFF_R2 + SZ_R2;
constexpr size_t WS_END = OFF_BAR + (size_t)4096 * 4;
static_assert(OFF_PC + (size_t)MTOT * 416 * 2 <= WS_END, "R2 overflow");
static_assert(OFF_OBT + (size_t)MTOT * 256 * 2 <= OFF_R2 + SZ_R2, "R2 overflow");
static_assert(WS_END <= (size_t)536870912, "workspace too large");

struct Params {
    const float* in[31];
    float* out;
    unsigned char* ws;
    int ph_lo, ph_hi;
};


typedef __attribute__((address_space(4))) const unsigned char* kargp_t;
DI kargp_t karg_base() { kargp_t k = (kargp_t)__builtin_amdgcn_kernarg_segment_ptr(); asm volatile("" : "+s"(k)); return k; }
#define GAS __attribute__((address_space(1)))
DI const float* INP(int i) { const float* q = *(const float* __attribute__((address_space(4))) const*)(karg_base() + 8 * i); return q; }
DI float* OUTP() { float* q = *(float* __attribute__((address_space(4))) const*)(karg_base() + 8 * 31); return q; }
DI unsigned char* WSP() { unsigned char* q = *(unsigned char* __attribute__((address_space(4))) const*)(karg_base() + 8 * 32); return q; }

DI float bf2f(bf16_t b) { return __uint_as_float(((unsigned)b) << 16); }
DI unsigned pack2(float a, float b) { f32x2 v = {a, b}; bf2_t r = __builtin_convertvector(v, bf2_t); return __builtin_bit_cast(unsigned, r); }
DI bf16_t f2bf(float a) { return (bf16_t)(pack2(a, 0.f) & 0xffffu); }
DI float wave_sum(float v) {
#pragma unroll
    for (int o = 32; o > 0; o >>= 1) v += __shfl_xor(v, o);
    return v;
}
DI float fast_exp2(float x) { return __builtin_amdgcn_exp2f(x); }
DI int otid() { int t = threadIdx.x; asm volatile("" : "+v"(t)); return t; }
DI int obid() { int t = blockIdx.x; asm volatile("" : "+s"(t)); return t; }
DI int crow(int reg, int h) { return (reg & 3) + 8 * (reg >> 2) + 4 * h; }
#define MFMA32(a, b, c) __builtin_amdgcn_mfma_f32_32x32x16_bf16((a), (b), (c), 0, 0, 0)

DI void conv_item(const Params& p, int it, LAS unsigned char* lds) {
    LAS float* tile = (LAS float*)lds;
    const int tid = otid();
    const int l = it / 2568; int r = it % 2568;
    int mat, K; size_t woff;
    if (r < 704) { mat = 0; K = 1024; woff = WO_GU1; }
    else if (r < 1056) { r -= 704; mat = 1; K = 2816; woff = WO_D1; }
    else if (r < 1760) { r -= 1056; mat = 2; K = 1024; woff = WO_GU2; }
    else if (r < 2112) { r -= 1760; mat = 3; K = 2816; woff = WO_D2; }
    else if (r < 2368) { r -= 2112; mat = 4; K = 1024; woff = WO_IN; }
    else if (r < 2496) { r -= 2368; mat = 5; K = 1024; woff = WO_OUT; }
    else { r -= 2496; mat = 6; K = 384; woff = WO_UP; }
    const int nK = K / 64, tn = r / nK, tk = r % nK, n0 = tn * 128, k0 = tk * 64;
    bf16_t* dst = (bf16_t*)(WSP() + OFF_W + (size_t)l * SZ_WL + woff);
    {
        const int kk = tid >> 7, n = n0 + (tid & 127);
        const float* sp; const float* sc = nullptr; int ld, klo = 0, khi = K; bool zero = false;
        if (mat == 0 || mat == 2) {
            const int tl_ = n >> 8, c_ = n & 255, bj_ = c_ >> 7, wc_ = (c_ >> 5) & 3, t_ = (c_ >> 4) & 1, fq_ = (c_ >> 2) & 3, j_ = c_ & 3;
            const int unit = tl_ * 128 + wc_ * 32 + fq_ * 8 + bj_ * 4 + j_, col = t_ * 2816 + unit;
            sp = (mat == 0 ? INP(6) : INP(8)) + (size_t)l * 1024 * 5632 + col; ld = 5632;
        } else if (mat == 1 || mat == 3) {
            sp = (mat == 1 ? INP(7) : INP(9)) + (size_t)l * 2816 * 1024 + n; ld = 1024;
        } else if (mat == 4) {
            const int an = (n & ~31) + 8 * ((n & 15) >> 2) + 4 * ((n >> 4) & 1) + (n & 3);
            zero = an >= 1824; sp = INP(12) + (size_t)l * 1024 * 1824 + (zero ? 0 : an); ld = 1824;
        } else if (mat == 5) {
            sp = INP(13) + (size_t)l * 1024 * 1024 + n; ld = 1024;
        } else {
            const int an = (n & ~31) + 8 * ((n & 15) >> 2) + 4 * ((n >> 4) & 1) + (n & 3);
            if (an < 576) { sp = INP(29) + (size_t)l * 256 * 576 + an; ld = 576; khi = 256; sc = INP(27) + l * 256; }
            else if (an < 1344) { sp = INP(30) + (size_t)l * 128 * 768 + (an - 576); ld = 768; klo = 256; sc = INP(28) + l * 128; }
            else { zero = true; sp = INP(29); ld = 0; sc = INP(27); }
        }
        const bool has_sc = (mat == 6);
        float v[16];
#pragma unroll
        for (int ps = 0; ps < 16; ++ps) {
            const int k = k0 + ps * 4 + kk;
            const bool valid = !zero && k >= klo && k < khi;
            const int idx = valid ? k - klo : 0;
            float x = sp[(size_t)idx * ld];
            if (has_sc) x *= sc[idx];
            v[ps] = valid ? x : 0.f;
        }
#pragma unroll
        for (int ps = 0; ps < 16; ++ps) tile[(ps * 4 + kk) * 129 + (tid & 127)] = v[ps];
    }
    __syncthreads();
    {
        const int nl = tid >> 2, kc = (tid & 3) * 16;
#pragma unroll
        for (int hh = 0; hh < 2; ++hh) {
            const int kb = kc + hh * 8;
            u32x4 o;
            o.x = pack2(tile[(kb + 0) * 129 + nl], tile[(kb + 1) * 129 + nl]);
            o.y = pack2(tile[(kb + 2) * 129 + nl], tile[(kb + 3) * 129 + nl]);
            o.z = pack2(tile[(kb + 4) * 129 + nl], tile[(kb + 5) * 129 + nl]);
            o.w = pack2(tile[(kb + 6) * 129 + nl], tile[(kb + 7) * 129 + nl]);
            *(u32x4*)(dst + (size_t)(n0 + nl) * K + k0 + kb) = o;
        }
    }
}

DI void mod_item(const Params& p, int it, LAS unsigned char* lds) {
    LAS float* s = (LAS float*)lds;
    LAS float* red = s + 12 * 1024;
    const int tid = otid();
    const int l = it / 144, jb = it % 144, j0 = jb * 64;
    {
        const float* cvec = INP(1); const float* cctx = INP(3);
        float vv[18];
#pragma unroll
        for (int q = 0; q < 18; ++q) { const int idx = tid + q * NTHR, r = idx >> 10, k = idx & 1023; vv[q] = r < 8 ? cvec[r * 1024 + k] : cctx[k]; }
#pragma unroll
        for (int q = 0; q < 18; ++q) { const int idx = tid + q * NTHR, r = idx >> 10, k = idx & 1023; s[k * 12 + r] = vv[q] / (1.f + __expf(-vv[q])); }
    }
    __syncthreads();
    const int jc = tid & 63, kg = tid >> 6;
    const float* w = INP(4) + (size_t)l * 1024 * 9216 + j0 + jc;
    float acc[9];
#pragma unroll
    for (int r = 0; r < 9; ++r) acc[r] = 0.f;
#pragma unroll 16
    for (int k = kg * 128; k < kg * 128 + 128; ++k) {
        const float wv = w[(size_t)k * 9216];
        const f32x4 s0 = *(const LAS f32x4*)(s + k * 12), s1 = *(const LAS f32x4*)(s + k * 12 + 4); const float s8 = s[k * 12 + 8];
        acc[0] += s0[0] * wv; acc[1] += s0[1] * wv; acc[2] += s0[2] * wv; acc[3] += s0[3] * wv;
        acc[4] += s1[0] * wv; acc[5] += s1[1] * wv; acc[6] += s1[2] * wv; acc[7] += s1[3] * wv; acc[8] += s8 * wv;
    }
#pragma unroll
    for (int r = 0; r < 9; ++r) red[(kg * 9 + r) * 64 + jc] = acc[r];
    __syncthreads();
    float* mod = (float*)(WSP() + OFF_MOD) + (size_t)l * 9 * 9216;
    const float* adab = INP(5);
    for (int idx = tid; idx < 9 * 64; idx += NTHR) {
        const int r = idx >> 6, c = idx & 63;
        float v = adab[l * 9216 + j0 + c];
#pragma unroll
        for (int g = 0; g < 8; ++g) v += red[(g * 9 + r) * 64 + c];
        mod[(size_t)r * 9216 + j0 + c] = v;
    }
}

DI void filt_item(const Params& p, int it, LAS unsigned char* lds) {
    const int tid = otid();
    const int l = it / 136; int r = it % 136;
    const int which = r < 128 ? 0 : 1; if (which) r -= 128;
    const int n = which ? 256 : 4096, t0 = r * 32;
    LAS float* z = (LAS float*)lds;
    LAS float* hA = z + 32 * 33;
    LAS float* hB = hA + 32 * 64;
    LAS bf16_t* ot = (LAS bf16_t*)(hB + 32 * 64);
    for (int idx = tid; idx < 32 * 33; idx += NTHR) {
        const int tt = idx / 33, e = idx % 33, ti = t0 + tt;
        float v;
        if (e == 0) v = (float)ti / (float)(n - 1);
        else {
            const int j = (e - 1) & 15;
            const float f = 1e-4f + (float)j * ((15.f - 1e-4f) / 15.f);
            const float w = 6.283185307179586f * (float)ti / (float)n;
            const float a = f * w;
            v = e <= 16 ? cosf(a) : -sinf(a);
        }
        z[idx] = v;
    }
    __syncthreads();
    const float* W1 = INP(18) + l * 33 * 64; const float* B1 = INP(19) + l * 64;
    const float* W2 = INP(20) + l * 64 * 64; const float* B2 = INP(21) + l * 64;
    const float* W3 = INP(22) + l * 64 * 64; const float* B3 = INP(23) + l * 64;
    const float* W4 = INP(24) + l * 64 * 512; const float* FR = INP(25) + l * 64;
    {
        const int j = tid & 63, t8 = tid >> 6;
        float a[4];
#pragma unroll
        for (int q = 0; q < 4; ++q) a[q] = B1[j];
#pragma unroll 11
        for (int e = 0; e < 33; ++e) { const float wv = W1[e * 64 + j];
#pragma unroll
            for (int q = 0; q < 4; ++q) a[q] += z[(t8 + 8 * q) * 33 + e] * wv; }
        const float fr = FR[j];
#pragma unroll
        for (int q = 0; q < 4; ++q) hA[(t8 + 8 * q) * 64 + j] = sinf(fr * a[q]);
        __syncthreads();
#pragma unroll
        for (int q = 0; q < 4; ++q) a[q] = B2[j];
#pragma unroll 16
        for (int e = 0; e < 64; ++e) { const float wv = W2[e * 64 + j];
#pragma unroll
            for (int q = 0; q < 4; ++q) a[q] += hA[(t8 + 8 * q) * 64 + e] * wv; }
#pragma unroll
        for (int q = 0; q < 4; ++q) hB[(t8 + 8 * q) * 64 + j] = sinf(fr * a[q]);
        __syncthreads();
#pragma unroll
        for (int q = 0; q < 4; ++q) a[q] = B3[j];
#pragma unroll 16
        for (int e = 0; e < 64; ++e) { const float wv = W3[e * 64 + j];
#pragma unroll
            for (int q = 0; q < 4; ++q) a[q] += hB[(t8 + 8 * q) * 64 + e] * wv; }
#pragma unroll
        for (int q = 0; q < 4; ++q) hA[(t8 + 8 * q) * 64 + j] = sinf(fr * a[q]);
        __syncthreads();
    }
    {
        const int col = tid, c = col & 255;
        const float a0 = -3.0701134573253942f, a1 = -15.350567286626972f;
        const float delta = fabsf(a0 + (float)c * ((a1 - a0) / 255.f));
        float part = 0.f;
        float w4r[64];
#pragma unroll
        for (int e = 0; e < 64; ++e) w4r[e] = W4[e * 512 + col];
#pragma unroll 1
        for (int tt = 0; tt < 32; ++tt) {
            float a = 0.f;
#pragma unroll
            for (int e = 0; e < 64; e += 4) { const f32x4 hv = *(const LAS f32x4*)(hA + tt * 64 + e);
                a += hv[0] * w4r[e] + hv[1] * w4r[e + 1] + hv[2] * w4r[e + 2] + hv[3] * w4r[e + 3]; }
            const int ti = t0 + tt;
            const float tl = (float)ti / (float)(n - 1);
            float v = a * __expf(-tl * delta);
            if (col >= 256 && ti == 0) v = 0.f;
            part += fabsf(v);
            ot[col * 32 + tt] = f2bf(v);
        }
        float* pp = which ? (float*)(WSP() + OFF_PARTC) + ((size_t)l * 8 + r) * 512 : (float*)(WSP() + OFF_PART) + ((size_t)l * 128 + r) * 512;
        pp[col] = part;
    }
    __syncthreads();
    bf16_t* kf = which ? (bf16_t*)(WSP() + OFF_KFC) + (size_t)l * 256 * 512 : (bf16_t*)(WSP() + OFF_KF) + (size_t)l * 256 * 8192;
    for (int idx = tid; idx < 512 * 32; idx += NTHR) {
        const int col = idx >> 5, tt = idx & 31, ti = t0 + tt, c = col & 255;
        const bf16_t v = ot[col * 32 + tt];
        if (col < 256) kf[(size_t)c * (2 * n) + n + ti] = v;
        else if (ti == 0) kf[(size_t)c * (2 * n)] = 0;
        else kf[(size_t)c * (2 * n) + n - ti] = v;
    }
}

DI void rope_item(const Params& p, int it) {
    const int e = it * NTHR + otid();
    const int pos = e / 48, a = e % 48;
    const int row = pos >> 6, col = pos & 63;
    float inv, coord;
    if (a < 32) { const int f = a & 15; inv = powf(10000.f, -(float)f / 16.f); coord = (float)(a < 16 ? row : col); }
    else { const int a2 = a - 32, f = a2 & 7; inv = powf(10000.f, -(float)f / 8.f); coord = (float)(a2 < 8 ? row : col); }
    const float ang = coord * inv;
    f32x2 cs = {cosf(ang), sinf(ang)};
    ((f32x2*)(WSP() + OFF_ROPE))[e] = cs;
}

#ifndef PPROBE
#define PPROBE 0
#endif
DI void phase_p0a(const Params& p, LAS unsigned char* lds) {
    constexpr int NMODI = 288, NFILT = 272, NROPE = 384, NCONV = 2 * 2568;
    constexpr int TOTAL = NMODI + NFILT + NROPE + NCONV;
    for (int it = obid(); it < TOTAL; it += gridDim.x) {
        unsigned long long pt0_ = 0; if (PPROBE) pt0_ = __builtin_amdgcn_s_memrealtime();
        if (it < NMODI) mod_item(p, it, lds);
        else if (it < NMODI + NFILT) filt_item(p, it - NMODI, lds);
        else if (it < NMODI + NFILT + NROPE) rope_item(p, it - NMODI - NFILT);
        else conv_item(p, it - NMODI - NFILT - NROPE, lds);
        __syncthreads();
        if (PPROBE) { const int ty = it < NMODI ? 1 : (it < NMODI + NFILT ? 2 : (it < NMODI + NFILT + NROPE ? 4 : 8));
            if ((PPROBE & ty) && threadIdx.x == 0) *(LAS unsigned long long*)(lds + LDS_BYTES - 32) += __builtin_amdgcn_s_memrealtime() - pt0_; }
    }
}

DI void phase_ln(const Params& p, int M, bool first, const float* g, const float* bta, bool do_mod, int lmod, int i_shift, int i_scale, bool write_out, int row0 = 0, int vb0 = 0, int vG = 0) {
    const int tid_ = otid(); const int lane = tid_ & 63, wv = tid_ >> 6;
    float* X = (float*)(WSP() + OFF_X);
    bf16_t* H = (bf16_t*)(WSP() + OFF_R1);
    const float* mod = (const float*)(WSP() + OFF_MOD) + (size_t)lmod * 9 * 9216;
    const int Gl = vG > 0 ? vG : (int)gridDim.x, vbl = obid() - vb0;
    if (vbl < 0 || vbl >= Gl) return;
    const float* xin = first ? INP(0) : nullptr; const float* cin = first ? INP(2) : nullptr;
#define LN_LOAD(r, dst) do { const float* src_ = first ? ((r) < MLAT ? xin + (size_t)(r) * D : cin + (size_t)((r) - MLAT) * D) : X + (size_t)(r) * D; \
        _Pragma("unroll") for (int q = 0; q < 4; ++q) dst[q] = *(const f32x4*)(src_ + q * 256 + lane * 4); } while (0)
    const int rstep = Gl * 8;
    f32x4 gg4[4], bb4[4];
#pragma unroll
    for (int q = 0; q < 4; ++q) { gg4[q] = (f32x4){1.f, 1.f, 1.f, 1.f}; bb4[q] = (f32x4){0.f, 0.f, 0.f, 0.f}; }
    if (!first) {
#pragma unroll
        for (int q = 0; q < 4; ++q) { gg4[q] = *(const f32x4*)(g + q * 256 + lane * 4); bb4[q] = *(const f32x4*)(bta + q * 256 + lane * 4); }
    }
    f32x4 v[4], vn[4];
    { const int r0_ = row0 + vbl * 8 + wv; if (r0_ < M) LN_LOAD(r0_, v); }
    for (int row = row0 + vbl * 8 + wv; row < M; row += rstep) {
        const bool more = row + rstep < M;
        if (more) LN_LOAD(row + rstep, vn);
        f32x4 sc4[4], sh4[4];
        if (do_mod) {
            const int bi_ = row < MLAT ? (row >> 12) : 8;
            const float* sh_ = mod + (size_t)bi_ * 9216 + i_shift * 1024; const float* sc_ = mod + (size_t)bi_ * 9216 + i_scale * 1024;
#pragma unroll
            for (int q = 0; q < 4; ++q) { sc4[q] = *(const f32x4*)(sc_ + q * 256 + lane * 4); sh4[q] = *(const f32x4*)(sh_ + q * 256 + lane * 4); }
        }
        if (!first) {
            float s = 0.f;
#pragma unroll
            for (int q = 0; q < 4; ++q) s += (v[q][0] + v[q][1]) + (v[q][2] + v[q][3]);
            const float mu = wave_sum(s) * (1.f / 1024.f);
            float ss = 0.f;
#pragma unroll
            for (int q = 0; q < 4; ++q) { const f32x4 d = v[q] - mu; ss += (d[0] * d[0] + d[1] * d[1]) + (d[2] * d[2] + d[3] * d[3]); }
            const float rstd = rsqrtf(wave_sum(ss) * (1.f / 1024.f) + EPS);
#pragma unroll
            for (int q = 0; q < 4; ++q) {
                v[q] = (v[q] - mu) * rstd * gg4[q] + bb4[q];
            }
        }
#pragma unroll
        for (int q = 0; q < 4; ++q) if (!write_out) *(f32x4*)(X + (size_t)row * D + q * 256 + lane * 4) = ALPHA * v[q];
        if (write_out && row < MLAT) {
#pragma unroll
            for (int q = 0; q < 4; ++q) *(f32x4*)(OUTP() + (size_t)row * D + q * 256 + lane * 4) = v[q];
        }
        if (do_mod) {
            float s = 0.f;
#pragma unroll
            for (int q = 0; q < 4; ++q) s += (v[q][0] + v[q][1]) + (v[q][2] + v[q][3]);
            const float mu = wave_sum(s) * (1.f / 1024.f);
            float ss = 0.f;
#pragma unroll
            for (int q = 0; q < 4; ++q) { const f32x4 d = v[q] - mu; ss += (d[0] * d[0] + d[1] * d[1]) + (d[2] * d[2] + d[3] * d[3]); }
            const float rstd = rsqrtf(wave_sum(ss) * (1.f / 1024.f) + EPS);
#pragma unroll
            for (int q = 0; q < 4; ++q) {
                const f32x4 s4 = sc4[q], h4 = sh4[q];
                const f32x4 o = (v[q] - mu) * rstd * (1.f + s4) + h4;
                u32x2 w; w.x = pack2(o[0], o[1]); w.y = pack2(o[2], o[3]);
                *(u32x2*)(H + (size_t)row * D + q * 256 + lane * 4) = w;
            }
        }
        if (more) {
#pragma unroll
            for (int q = 0; q < 4; ++q) v[q] = vn[q];
        }
    }
#undef LN_LOAD
}

namespace gm {
constexpr int BM = 256, BK = 64, HALF = 128, HTB = HALF * BK * 2, NXCD = 8, WGM = 8;
DI int lds_byte(int r, int c) { const int st = (r >> 4) * 2 + (c >> 5), rr = r & 15, cc = c & 31, ob = rr * 64 + cc * 2; return st * 1024 + (ob ^ (((ob >> 9) & 1) << 5)); }
DI void stage_rc(int b, int& R, int& C) { const int st = b / 1024, sb = b % 1024, swz = sb ^ (((sb >> 9) & 1) << 5); R = (st >> 1) * 16 + swz / 64; C = (st & 1) * 32 + (swz % 64) / 2; }

struct EpiSwiglu {
    static constexpr bool SPLITK = false;
    bf16_t* act;
    DI void operator()(const f32x4 (&acc)[2][2][4][2], int pm, int pn, int wr, int wc, int fr, int fq, bool) const {
        const int unit0 = pn * 128 + wc * 32 + fq * 8;
#pragma unroll
        for (int ai = 0; ai < 2; ++ai)
#pragma unroll
            for (int m = 0; m < 4; ++m) {
                const int row = pm * 256 + ai * 128 + wr * 64 + m * 16 + fr;
                float o[8];
#pragma unroll
                for (int bj = 0; bj < 2; ++bj) {
                    const f32x4 gt = acc[ai][bj][m][0], up = acc[ai][bj][m][1];
#pragma unroll
                    for (int j = 0; j < 4; ++j) o[bj * 4 + j] = gt[j] * __builtin_amdgcn_rcpf(1.f + __expf(-gt[j])) * up[j];
                }
                u32x4 w; w.x = pack2(o[0], o[1]); w.y = pack2(o[2], o[3]); w.z = pack2(o[4], o[5]); w.w = pack2(o[6], o[7]);
                *(u32x4*)(act + (size_t)row * DFF + unit0) = w;
            }
    }
};
struct EpiResid {
    static constexpr bool SPLITK = false;
    float* X; const float* gate; float coef;
    DI void operator()(const f32x4 (&acc)[2][2][4][2], int pm, int pn, int wr, int wc, int fr, int fq, bool) const {
        const int row0 = pm * 256 + wr * 64 + fr;
        const int bi = row0 < MLAT ? (row0 >> 12) : 8;
        const int col0 = pn * 256 + wc * 32 + fq * 4;
        f32x4 gv[2][2];
#pragma unroll
        for (int bj = 0; bj < 2; ++bj)
#pragma unroll
            for (int n = 0; n < 2; ++n) gv[bj][n] = coef * *(const f32x4*)(gate + (size_t)bi * 9216 + col0 + bj * 128 + n * 16);
        f32x4 xc[2][2], xn[2][2];
#define ER_LOAD(dst, g) do { float* xp_ = X + (size_t)(row0 + ((g) >> 2) * 128 + ((g) & 3) * 16) * D + col0; \
        _Pragma("unroll") for (int bj = 0; bj < 2; ++bj) _Pragma("unroll") for (int n = 0; n < 2; ++n) dst[bj][n] = *(const f32x4*)(xp_ + bj * 128 + n * 16); } while (0)
        ER_LOAD(xc, 0);
#pragma unroll
        for (int g = 0; g < 8; ++g) {
            if (g + 1 < 8) ER_LOAD(xn, g + 1);
            float* xp = X + (size_t)(row0 + (g >> 2) * 128 + (g & 3) * 16) * D + col0;
#pragma unroll
            for (int bj = 0; bj < 2; ++bj)
#pragma unroll
                for (int n = 0; n < 2; ++n) *(f32x4*)(xp + bj * 128 + n * 16) = xc[bj][n] + gv[bj][n] * acc[g >> 2][bj][g & 3][n];
#pragma unroll
            for (int bj = 0; bj < 2; ++bj)
#pragma unroll
                for (int n = 0; n < 2; ++n) xc[bj][n] = xn[bj][n];
        }
#undef ER_LOAD
    }
};
struct EpiWin {
    static constexpr bool SPLITK = false;
    bf16_t* pa; bf16_t* pbb; bf16_t* pc;
    DI void operator()(const f32x4 (&acc)[2][2][4][2], int pm, int pn, int wr, int wc, int fr, int fq, bool) const {
#pragma unroll
        for (int ai = 0; ai < 2; ++ai)
#pragma unroll
            for (int m = 0; m < 4; ++m) {
                const int row = pm * 256 + ai * 128 + wr * 64 + m * 16 + fr;
#pragma unroll
                for (int bj = 0; bj < 2; ++bj) {
                    const int col = pn * 256 + bj * 128 + wc * 32 + fq * 8;
                    const f32x4 a = acc[ai][bj][m][0], b = acc[ai][bj][m][1];
                    u32x4 w; w.x = pack2(a[0], a[1]); w.y = pack2(a[2], a[3]); w.z = pack2(b[0], b[1]); w.w = pack2(b[2], b[3]);
                    if (col < 640) *(u32x4*)(pa + (size_t)row * 640 + col) = w;
                    else if (col < 1408) *(u32x4*)(pbb + (size_t)row * 768 + (col - 640)) = w;
                    else if (col < 1824) *(u32x4*)(pc + (size_t)row * 416 + (col - 1408)) = w;
                }
            }
    }
};
struct EpiUp {
    static constexpr bool SPLITK = false;
    bf16_t* upb; float qscale;
    DI void operator()(const f32x4 (&acc)[2][2][4][2], int pm, int pn, int wr, int wc, int fr, int fq, bool) const {
#pragma unroll
        for (int ai = 0; ai < 2; ++ai)
#pragma unroll
            for (int m = 0; m < 4; ++m) {
                const int row = pm * 256 + ai * 128 + wr * 64 + m * 16 + fr;
#pragma unroll
                for (int bj = 0; bj < 2; ++bj) {
                    const int col = pn * 256 + bj * 128 + wc * 32 + fq * 8;
                    if (col < 1344) {
                        const float sc = col < 576 ? qscale : 1.f;
                        const f32x4 a = acc[ai][bj][m][0] * sc, b = acc[ai][bj][m][1] * sc;
                        u32x4 w; w.x = pack2(a[0], a[1]); w.y = pack2(a[2], a[3]); w.z = pack2(b[0], b[1]); w.w = pack2(b[2], b[3]);
                        *(u32x4*)(upb + (size_t)row * 1344 + col) = w;
                    }
                }
            }
    }
};

#define G_SA(b, h) (((b) * 2 + (h)) * HTB)
#define G_SB(b, h) ((4 + (b) * 2 + (h)) * HTB)
#define G_STAGE(bufoff, gbase, voff) do { _Pragma("unroll") for (int _i = 0; _i < 2; ++_i) \
        __builtin_amdgcn_global_load_lds((const unsigned*)((const char*)(gbase) + (voff)[_i]), (LAS unsigned*)(lds + (bufoff) + ldsw + _i * 8192), 16, 0, 0); } while (0)
#define G_LDA(dst, b, h) do { _Pragma("unroll") for (int m = 0; m < 4; ++m) _Pragma("unroll") for (int k = 0; k < 2; ++k) dst[m][k] = *(const LAS bf16x8*)(lds + G_SA(b, h) + aoff + m * 2048 + k * 1024); } while (0)
#define G_LDB(dst, b, h) do { _Pragma("unroll") for (int n = 0; n < 2; ++n) _Pragma("unroll") for (int k = 0; k < 2; ++k) dst[n][k] = *(const LAS bf16x8*)(lds + G_SB(b, h) + boff + n * 2048 + k * 1024); } while (0)
#define G_MMA(ai, bj, At, Bt) do { __builtin_amdgcn_s_setprio(1); _Pragma("unroll") for (int k = 0; k < 2; ++k) _Pragma("unroll") for (int m = 0; m < 4; ++m) _Pragma("unroll") for (int n = 0; n < 2; ++n) \
        acc[ai][bj][m][n] = __builtin_amdgcn_mfma_f32_16x16x32_bf16(Bt[n][k], At[m][k], acc[ai][bj][m][n], 0, 0, 0); __builtin_amdgcn_s_setprio(0); } while (0)
#define G_WAIT_V(n) asm volatile("s_waitcnt vmcnt(" #n ")" ::: "memory")
#define G_WAIT_L(n) asm volatile("s_waitcnt lgkmcnt(" #n ")" ::: "memory")
#define G_BAR __builtin_amdgcn_s_barrier()
#define G_SCHED __builtin_amdgcn_sched_barrier(0)

template <class Epi>
DI void gemm_phase(LAS unsigned char* lds, const bf16_t* A, int lda, const bf16_t* Bt, int ldb, int M, int N, int K, const Epi& epi, int pm0 = 0, int vb0 = 0, int vG = 0) {
    const int tid = otid(), wid = __builtin_amdgcn_readfirstlane(tid >> 6), lane = tid & 63, wr = wid >> 2, wc = wid & 3, fr = lane & 15, fq = lane >> 4;
    const int nt = K / BK, nM = M / BM, nN = N / BM, nwg = nM * nN;
    const int G = vG > 0 ? vG : (int)gridDim.x;
    const int vb = obid() - vb0;
    if (vb < 0 || vb >= G || vb >= nwg) return;
    unsigned voffA[2], voffB[2];
#pragma unroll
    for (int i = 0; i < 2; ++i) { int R, C; stage_rc(tid * 16 + i * 8192, R, C); voffA[i] = (unsigned)(R * lda + C) * 2u; voffB[i] = (unsigned)(R * ldb + C) * 2u; }
    const unsigned ldsw = (unsigned)wid * 1024u;
    const int aoff = lds_byte(wr * 64 + fr, fq * 8), boff = lds_byte(wc * 32 + fr, fq * 8);
    const size_t kstep = (size_t)(BK * 2), hA = (size_t)HALF * lda * 2, hB = (size_t)HALF * ldb * 2;
#define G_COORDS(Lx, pmx, pnx) do { int wgid = (Lx); \
        { const int q = nwg / NXCD, r = nwg % NXCD, xcd = wgid % NXCD, off = wgid / NXCD; wgid = (xcd < r ? xcd * (q + 1) : r * (q + 1) + (xcd - r) * q) + off; } \
        const int nig = WGM * nN, gid = wgid / nig, fm = gid * WGM, gsz = (nM - fm) < WGM ? (nM - fm) : WGM; \
        pmx = pm0 + fm + ((wgid % nig) % gsz); pnx = (wgid % nig) / gsz; } while (0)
    int pm, pn; G_COORDS(vb, pm, pn);
    const char* cA = (const char*)(A + (size_t)pm * BM * lda);
    const char* cB = (const char*)(Bt + (size_t)pn * BM * ldb);
    f32x4 acc[2][2][4][2];
#pragma unroll
    for (int a = 0; a < 2; ++a)
#pragma unroll
        for (int b = 0; b < 2; ++b)
#pragma unroll
            for (int m = 0; m < 4; ++m)
#pragma unroll
                for (int n = 0; n < 2; ++n) acc[a][b][m][n] = (f32x4){0.f, 0.f, 0.f, 0.f};
    bf16x8 At[4][2], B0[2][2], B1[2][2];
    G_STAGE(G_SB(0, 0), cB, voffB); G_STAGE(G_SB(0, 1), cB + hB, voffB); G_STAGE(G_SA(0, 0), cA, voffA); G_STAGE(G_SA(0, 1), cA + hA, voffA);
    if (wr == 1) G_BAR;
    G_WAIT_V(2); G_BAR;
    G_STAGE(G_SB(1, 0), cB + kstep, voffB); G_STAGE(G_SA(1, 0), cA + kstep, voffA); G_STAGE(G_SB(1, 1), cB + hB + kstep, voffB);
    G_WAIT_V(6); G_BAR;
    for (int wu = vb;;) {
        const int wn = wu + G;
        const bool has_next = wn < nwg;
        int pmn = pm, pnn = pn;
        if (has_next) G_COORDS(wn, pmn, pnn);
        const char* nA = has_next ? (const char*)(A + (size_t)pmn * BM * lda) : cA;
        const char* nB = has_next ? (const char*)(Bt + (size_t)pnn * BM * ldb) : cB;
        for (int t = 0; t < nt; t += 2) {
            const bool last = (t == nt - 2);
            const char* a1 = cA + (size_t)(t + 1) * kstep;
            const char* a2 = last ? nA : cA + (size_t)(t + 2) * kstep; const char* b2 = last ? nB : cB + (size_t)(t + 2) * kstep;
            const char* a3 = a2 + kstep; const char* b3 = b2 + kstep;
            G_LDB(B0, 0, 0); G_LDB(B1, 0, 1); G_SCHED; G_LDA(At, 0, 0); G_STAGE(G_SA(1, 1), a1 + hA, voffA);
            G_WAIT_V(8); G_WAIT_L(0); G_BAR; G_MMA(0, 0, At, B0); G_MMA(0, 1, At, B1); G_BAR; G_SCHED;
            G_LDA(At, 0, 1); G_STAGE(G_SB(0, 0), b2, voffB); G_STAGE(G_SB(0, 1), b2 + hB, voffB); G_STAGE(G_SA(0, 0), a2, voffA);
            G_WAIT_V(8); G_WAIT_L(0); G_BAR; G_MMA(1, 0, At, B0); G_MMA(1, 1, At, B1); G_BAR; G_SCHED;
            G_LDB(B0, 1, 0); G_LDB(B1, 1, 1); G_SCHED; G_LDA(At, 1, 0); G_STAGE(G_SA(0, 1), a2 + hA, voffA);
            G_WAIT_V(8); G_WAIT_L(0); G_BAR; G_MMA(0, 0, At, B0); G_MMA(0, 1, At, B1); G_BAR; G_SCHED;
            G_LDA(At, 1, 1); G_STAGE(G_SB(1, 0), b3, voffB); G_STAGE(G_SB(1, 1), b3 + hB, voffB); G_STAGE(G_SA(1, 0), a3, voffA);
            G_WAIT_V(8); G_WAIT_L(0); G_BAR; G_MMA(1, 0, At, B0); G_MMA(1, 1, At, B1); G_BAR; G_SCHED;
        }
        if (wr == 0) G_BAR;
        epi(acc, pm, pn, wr, wc, fr, fq, false);
        if (!has_next) break;
#pragma unroll
        for (int a = 0; a < 2; ++a)
#pragma unroll
            for (int b = 0; b < 2; ++b)
#pragma unroll
                for (int m = 0; m < 4; ++m)
#pragma unroll
                    for (int n = 0; n < 2; ++n) acc[a][b][m][n] = (f32x4){0.f, 0.f, 0.f, 0.f};
        pm = pmn; pn = pnn; cA = nA; cB = nB; wu = wn;
        if (wr == 1) G_BAR;
    }
    G_WAIT_V(0);
    G_BAR;
#undef G_COORDS
    __syncthreads();
}
}


DI void phase_post(const Params& p, int l, LAS unsigned char* lds) {
    const int tid_ = otid(); const int lane = tid_ & 63, wv = tid_ >> 6;
    bf16_t* PA = (bf16_t*)(WSP() + OFF_PA);
    const bf16_t* PBB = (const bf16_t*)(WSP() + OFF_PBB);
    const bf16_t* PC = (const bf16_t*)(WSP() + OFF_PC);
    bf16_t* HYU = (bf16_t*)(WSP() + OFF_HYU);
    bf16_t* HYX = (bf16_t*)(WSP() + OFF_HYX);
    bf16_t* KR = (bf16_t*)(WSP() + OFF_KR);
    bf16_t* CN = (bf16_t*)(WSP() + OFF_R1);
    const f32x2* ROPE = (const f32x2*)(WSP() + OFF_ROPE);
    const int hd = lane >> 3, e0 = (lane & 7) * 8;
    float g8[8];
#pragma unroll
    for (int j = 0; j < 8; ++j) g8[j] = (hd < 6 ? INP(14)[l * 64 + e0 + j] : INP(15)[l * 64 + e0 + j]) * (hd < 6 ? 0.125f * LOG2E : 1.f);
    const float* cw = INP(16) + (size_t)l * 3 * 768;
    const float* cb = INP(17) + (size_t)l * 768;
    f32x4 w0[3], w1[3], w2[3], wb[3];
#pragma unroll
    for (int g3 = 0; g3 < 3; ++g3) {
        const int col = g3 * 256 + 4 * lane;
        w0[g3] = *(const f32x4*)(cw + col); w1[g3] = *(const f32x4*)(cw + 768 + col); w2[g3] = *(const f32x4*)(cw + 1536 + col); wb[g3] = *(const f32x4*)(cb + col);
    }
    LAS bf16_t* UT = (LAS bf16_t*)lds;
    LAS bf16_t* XT = UT + 256 * 40;
    for (int tile = obid(); tile < MTOT / 32; tile += gridDim.x) {
      for (int tq = 0; tq < 4; ++tq) {
        const int tt = wv * 4 + tq, tok = tile * 32 + tt;
        const bool lat = tok < MLAT;
        const int t = lat ? (tok & 4095) : ((tok - MLAT) & 255);
        const int n = lat ? SEQ : CTXL;
        bf16_t* pa = PA + (size_t)tok * 640 + lane * 8;
        const u32x4 raw = *(const u32x4*)pa;
        const bf16_t* r0 = PBB + (size_t)tok * 768 + 4 * lane;
        u32x2 c0v[3], cmv[3], cpv[3];
#pragma unroll
        for (int g3 = 0; g3 < 3; ++g3) {
            c0v[g3] = *(const u32x2*)(r0 + g3 * 256);
            cmv[g3] = (u32x2){0u, 0u}; cpv[g3] = (u32x2){0u, 0u};
            if (t > 0) cmv[g3] = *(const u32x2*)(r0 + g3 * 256 - 768);
            if (t < n - 1) cpv[g3] = *(const u32x2*)(r0 + g3 * 256 + 768);
        }
        const bf16_t* pc = PC + (size_t)tok * 416;
        const u32x2 cq = *(const u32x2*)(pc + 4 * lane);
        const unsigned ck = *(const unsigned*)(pc + 256 + 2 * lane);
        const bf16_t krraw = pc[384 + (lane & 31)];
        f32x2 csa[8]; f32x2 csk = {1.f, 0.f};
        if (lat) {
            const f32x2* cs = ROPE + (size_t)t * 48 + (lane & 3) * 8;
#pragma unroll
            for (int j = 0; j < 8; ++j) csa[j] = cs[j];
            csk = ROPE[(size_t)t * 48 + 32 + (lane & 15)];
        }
        {
            float x[8];
#pragma unroll
            for (int j = 0; j < 4; ++j) { x[2 * j] = __uint_as_float(raw[j] << 16); x[2 * j + 1] = __uint_as_float(raw[j] & 0xffff0000u); }
            float ss = 0.f;
#pragma unroll
            for (int j = 0; j < 8; ++j) ss += x[j] * x[j];
            ss += __shfl_xor(ss, 1); ss += __shfl_xor(ss, 2); ss += __shfl_xor(ss, 4);
            const float r = rsqrtf(ss * (1.f / 64.f) + EPS);
#pragma unroll
            for (int j = 0; j < 8; ++j) x[j] *= r * g8[j];
            if (lat) {
#pragma unroll
                for (int j = 0; j < 8; ++j) {
                    const float pr = __shfl_xor(x[j], 4);
                    const f32x2 c = csa[j];
                    x[j] = (lane & 4) ? x[j] * c[0] + pr * c[1] : x[j] * c[0] - pr * c[1];
                }
            }
            u32x4 o; o.x = pack2(x[0], x[1]); o.y = pack2(x[2], x[3]); o.z = pack2(x[4], x[5]); o.w = pack2(x[6], x[7]);
            *(u32x4*)pa = o;
        }
        {
            f32x4 o[3];
#pragma unroll
            for (int g3 = 0; g3 < 3; ++g3) {
                const u32x2 c0 = c0v[g3], cm = cmv[g3], cp = cpv[g3];
                const f32x4 vm = {__uint_as_float(cm.x << 16), __uint_as_float(cm.x & 0xffff0000u), __uint_as_float(cm.y << 16), __uint_as_float(cm.y & 0xffff0000u)};
                const f32x4 v0 = {__uint_as_float(c0.x << 16), __uint_as_float(c0.x & 0xffff0000u), __uint_as_float(c0.y << 16), __uint_as_float(c0.y & 0xffff0000u)};
                const f32x4 vp = {__uint_as_float(cp.x << 16), __uint_as_float(cp.x & 0xffff0000u), __uint_as_float(cp.y << 16), __uint_as_float(cp.y & 0xffff0000u)};
                o[g3] = w0[g3] * vm + w1[g3] * v0 + w2[g3] * vp + wb[g3];
            }
            const f32x4 u = o[0] * o[1];
            u32x2 a; a.x = pack2(u[0], u[1]); a.y = pack2(u[2], u[3]);
            u32x2 b; b.x = pack2(o[2][0], o[2][1]); b.y = pack2(o[2][2], o[2][3]);
#pragma unroll
            for (int j = 0; j < 4; ++j) {
                const unsigned ua = (j & 1) ? ((j < 2 ? a.x : a.y) >> 16) : ((j < 2 ? a.x : a.y) & 0xffffu);
                const unsigned ub = (j & 1) ? ((j < 2 ? b.x : b.y) >> 16) : ((j < 2 ? b.x : b.y) & 0xffffu);
                UT[(4 * lane + j) * 40 + tt] = (bf16_t)ua; XT[(4 * lane + j) * 40 + tt] = (bf16_t)ub;
            }
        }
        {
            const f32x4 v = {__uint_as_float(cq.x << 16), __uint_as_float(cq.x & 0xffff0000u), __uint_as_float(cq.y << 16), __uint_as_float(cq.y & 0xffff0000u)};
            const float rq = rsqrtf(wave_sum((v[0] * v[0] + v[1] * v[1]) + (v[2] * v[2] + v[3] * v[3])) * (1.f / 256.f) + EPS);
            u32x2 oq; oq.x = pack2(v[0] * rq, v[1] * rq); oq.y = pack2(v[2] * rq, v[3] * rq);
            *(u32x2*)(CN + (size_t)tok * 384 + 4 * lane) = oq;
            const float u0 = __uint_as_float(ck << 16), u1 = __uint_as_float(ck & 0xffff0000u);
            const float rk = rsqrtf(wave_sum(u0 * u0 + u1 * u1) * (1.f / 128.f) + EPS);
            *(unsigned*)(CN + (size_t)tok * 384 + 256 + 2 * lane) = pack2(u0 * rk, u1 * rk);
            float kr = bf2f(krraw);
            const float pr = __shfl_xor(kr, 16);
            if (lat) kr = (lane & 16) ? kr * csk[0] + pr * csk[1] : kr * csk[0] - pr * csk[1];
            if (lane < 32) KR[(size_t)tok * 32 + lane] = f2bf(kr);
        }
      }
      __syncthreads();
      {
          const int ch = tid_ >> 1, half = tid_ & 1;
          const u32x4 u0 = *(const LAS u32x4*)(UT + ch * 40 + 16 * half), u1 = *(const LAS u32x4*)(UT + ch * 40 + 16 * half + 8);
          const u32x4 x0 = *(const LAS u32x4*)(XT + ch * 40 + 16 * half), x1 = *(const LAS u32x4*)(XT + ch * 40 + 16 * half + 8);
          bf16_t* du = HYU + (size_t)ch * MTOT + tile * 32 + 16 * half; bf16_t* dx = HYX + (size_t)ch * MTOT + tile * 32 + 16 * half;
          *(u32x4*)du = u0; *(u32x4*)(du + 8) = u1; *(u32x4*)dx = x0; *(u32x4*)(dx + 8) = x1;
      }
      __syncthreads();
    }
}

template <int DQK>
DI void attn_item(LAS unsigned char* lds, const bf16_t* qbase, int q_ld, const bf16_t* kc, const bf16_t* kl, const bf16_t* vc, const bf16_t* vl, int kv_ld,
                  const bf16_t* krc, const bf16_t* krl, int ntiles, bf16_t* obase, const f32x2* rope) {
    constexpr int KS = DQK + 8, VS = 68, KBYTES = 64 * KS * 2, BUF = KBYTES + 64 * VS * 2, NKK = DQK / 16;
    const int tid = otid(), lane = tid & 63, w = tid >> 6, li = lane & 31, h = lane >> 5;
    bf16x8 qf[NKK];
    {
        const bf16_t* qrow = qbase + (size_t)(32 * w + li) * q_ld;
#pragma unroll
        for (int kk = 0; kk < NKK; ++kk) qf[kk] = *(const bf16x8*)(qrow + 16 * kk + 8 * h);
        if (DQK == 96 && rope != nullptr) {
            const f32x2* cs = rope + (size_t)(32 * w + li) * 48 + 8 * h;
            bf16x8 a = qf[NKK - 2], b = qf[NKK - 1];
#pragma unroll
            for (int j = 0; j < 8; ++j) {
                const float x1 = bf2f((bf16_t)a[j]), x2 = bf2f((bf16_t)b[j]);
                const f32x2 c = cs[j];
                a[j] = (short)f2bf(x1 * c[0] - x2 * c[1]);
                b[j] = (short)f2bf(x2 * c[0] + x1 * c[1]);
            }
            qf[NKK - 2] = a; qf[NKK - 1] = b;
        }
    }
    f32x16 ot[2];
#pragma unroll
    for (int i = 0; i < 16; ++i) { ot[0][i] = 0.f; ot[1][i] = 0.f; }
    float m_run = -INFINITY, l_run = 0.f;
    const int kkey = tid >> 3, kch = tid & 7;
    const int vkey = lane, vch = w;
    const int rkey = tid >> 2, rch = tid & 3;
    u32x4 kreg, vreg, rreg;
    const unsigned voffK = (unsigned)(kkey * kv_ld + 8 * kch) * 2u, voffV = (unsigned)(vkey * kv_ld + 8 * vch) * 2u, voffR = (unsigned)(rkey * 32 + 8 * rch) * 2u;
#define ATT_LOAD(j) do { const int s0 = (j) * 64; \
        const char* kb_ = (const char*)(s0 < CTXL ? kc + (size_t)s0 * kv_ld : kl + (size_t)(s0 - CTXL) * kv_ld); \
        const char* vb_ = (const char*)(s0 < CTXL ? vc + (size_t)s0 * kv_ld : vl + (size_t)(s0 - CTXL) * kv_ld); \
        kreg = *(const u32x4*)(kb_ + voffK); \
        vreg = *(const u32x4*)(vb_ + voffV); \
        if (DQK == 96 && tid < 256) { const char* rb = (const char*)(s0 < CTXL ? krc + (size_t)s0 * 32 : krl + (size_t)(s0 - CTXL) * 32); rreg = *(const u32x4*)(rb + voffR); } } while (0)
#define ATT_STORE(bufi) do { LAS unsigned char* kb_ = lds + (bufi) * BUF; LAS bf16_t* vt_ = (LAS bf16_t*)(kb_ + KBYTES); \
        *(LAS u32x4*)(kb_ + (kkey * KS + 8 * kch) * 2) = kreg; \
        if (DQK == 96 && tid < 256) *(LAS u32x4*)(kb_ + (rkey * KS + 64 + 8 * rch) * 2) = rreg; \
        _Pragma("unroll") for (int e = 0; e < 4; ++e) { const unsigned wd = vreg[e]; vt_[(8 * vch + 2 * e) * VS + vkey] = (bf16_t)(wd & 0xffffu); vt_[(8 * vch + 2 * e + 1) * VS + vkey] = (bf16_t)(wd >> 16); } } while (0)
    ATT_LOAD(0);
    ATT_STORE(0);
    __syncthreads();
    bf16x8 vf[2][2][2];
    f32x16 st[2];
#define ATT_X(j) do { \
        const LAS unsigned char* kb = lds + ((j) & 1) * BUF; const LAS unsigned char* vt = kb + KBYTES; \
        bf16x8 kf[2][NKK]; \
        _Pragma("unroll") for (int kt = 0; kt < 2; ++kt) _Pragma("unroll") for (int kk = 0; kk < NKK; ++kk) kf[kt][kk] = *(const LAS bf16x8*)(kb + ((32 * kt + li) * KS + 16 * kk + 8 * h) * 2); \
        _Pragma("unroll") for (int vtile = 0; vtile < 2; ++vtile) _Pragma("unroll") for (int kt = 0; kt < 2; ++kt) _Pragma("unroll") for (int s = 0; s < 2; ++s) { \
            const LAS unsigned char* ap = vt + ((32 * vtile + li) * VS + 32 * kt + 16 * s + 4 * h) * 2; \
            const u32x2 lo = *(const LAS u32x2*)ap, hi = *(const LAS u32x2*)(ap + 16); \
            u32x4 vv; vv.x = lo.x; vv.y = lo.y; vv.z = hi.x; vv.w = hi.y; vf[vtile][kt][s] = __builtin_bit_cast(bf16x8, vv); } \
        _Pragma("unroll") for (int kt = 0; kt < 2; ++kt) { \
            _Pragma("unroll") for (int i = 0; i < 16; ++i) st[kt][i] = 0.f; \
            _Pragma("unroll") for (int kk = 0; kk < NKK; ++kk) st[kt] = MFMA32(kf[kt][kk], qf[kk], st[kt]); } } while (0)
#define ATT_Y() do { \
        float mx = fmaxf(fmaxf(st[0][0], st[0][1]), st[0][2]); \
        _Pragma("unroll") for (int i = 3; i < 15; i += 2) mx = fmaxf(fmaxf(mx, st[0][i]), st[0][i + 1]); \
        mx = fmaxf(mx, st[0][15]); \
        _Pragma("unroll") for (int i = 0; i < 16; i += 2) mx = fmaxf(fmaxf(mx, st[1][i]), st[1][i + 1]); \
        mx = fmaxf(mx, __shfl_xor(mx, 32)); \
        if (__any(mx > m_run + 8.f)) { \
            const float m_new = fmaxf(m_run, mx); const float alpha = fast_exp2(m_run - m_new); m_run = m_new; l_run *= alpha; \
            _Pragma("unroll") for (int i = 0; i < 16; ++i) { ot[0][i] *= alpha; ot[1][i] *= alpha; } } \
        { const f32x2 m2 = {m_run, m_run}; f32x2 rs2 = {0.f, 0.f}; \
          _Pragma("unroll") for (int kt = 0; kt < 2; ++kt) _Pragma("unroll") for (int i = 0; i < 16; i += 2) { \
              f32x2 d = (f32x2){st[kt][i], st[kt][i + 1]} - m2; d[0] = fast_exp2(d[0]); d[1] = fast_exp2(d[1]); rs2 += d; st[kt][i] = d[0]; st[kt][i + 1] = d[1]; } \
          l_run += rs2[0] + rs2[1]; } \
        _Pragma("unroll") for (int kt = 0; kt < 2; ++kt) _Pragma("unroll") for (int s = 0; s < 2; ++s) { \
            u32x4 pk; pk.x = pack2(st[kt][8 * s + 0], st[kt][8 * s + 1]); pk.y = pack2(st[kt][8 * s + 2], st[kt][8 * s + 3]); \
            pk.z = pack2(st[kt][8 * s + 4], st[kt][8 * s + 5]); pk.w = pack2(st[kt][8 * s + 6], st[kt][8 * s + 7]); \
            const bf16x8 pf = __builtin_bit_cast(bf16x8, pk); \
            ot[0] = MFMA32(vf[0][kt][s], pf, ot[0]); ot[1] = MFMA32(vf[1][kt][s], pf, ot[1]); } } while (0)
    if (w < 4) {
        for (int j = 0; j < ntiles; ++j) {
            if (j + 1 < ntiles) ATT_LOAD(j + 1);
            ATT_X(j);
            __builtin_amdgcn_s_barrier();
            ATT_Y();
            if (j + 1 < ntiles) ATT_STORE((j + 1) & 1);
            asm volatile("s_waitcnt lgkmcnt(0)" ::: "memory");
            __builtin_amdgcn_s_barrier();
        }
        __builtin_amdgcn_s_barrier();
    } else {
        if (1 < ntiles) ATT_LOAD(1);
        __builtin_amdgcn_s_barrier();
        for (int j = 0; j < ntiles; ++j) {
            ATT_X(j);
            if (j + 1 < ntiles) ATT_STORE((j + 1) & 1);
            asm volatile("s_waitcnt lgkmcnt(0)" ::: "memory");
            __builtin_amdgcn_s_barrier();
            if (j + 2 < ntiles) ATT_LOAD(j + 2);
            ATT_Y();
            __builtin_amdgcn_s_barrier();
        }
    }
#undef ATT_X
#undef ATT_Y
#undef ATT_LOAD
#undef ATT_STORE
    const float lt = l_run + __shfl_xor(l_run, 32);
    const float inv = 1.f / lt;
    bf16_t* orow = obase + (size_t)(32 * w + li) * 1024;
#pragma unroll
    for (int vtile = 0; vtile < 2; ++vtile)
#pragma unroll
        for (int g4 = 0; g4 < 4; ++g4) {
            u32x2 o; o.x = pack2(ot[vtile][4 * g4 + 0] * inv, ot[vtile][4 * g4 + 1] * inv); o.y = pack2(ot[vtile][4 * g4 + 2] * inv, ot[vtile][4 * g4 + 3] * inv);
            *(u32x2*)(orow + 32 * vtile + 8 * g4 + 4 * h) = o;
        }
}

#ifndef HYPROBE
#define HYPROBE 0
#endif
template <int NBLK>
DI void hyena_item(LAS unsigned char* lds, const bf16_t* kf, float inv_norm, float dskip, const bf16_t* hyu, const bf16_t* hyx, bf16_t* mix, int tok0) {
    constexpr int n = 64 * NBLK, CL = 2 * n + 32, NCT = NBLK >= 64 ? 2 : 1;
    const int tid = otid(), lane = tid & 63, w = tid >> 6, li = lane & 31, h = lane >> 5;
    LAS bf16_t* cp = (LAS bf16_t*)lds;
    LAS bf16_t* U = cp + 4 * CL;
    for (int ch = tid; ch < (2 * n) / 8; ch += NTHR) {
        const u32x4 raw = *(const u32x4*)(kf + 8 * ch);
#pragma unroll
        for (int e = 0; e < 8; ++e) {
            const bf16_t v = (e & 1) ? (bf16_t)(raw[e >> 1] >> 16) : (bf16_t)(raw[e >> 1] & 0xffffu);
            const int x = 8 * ch + e;
#pragma unroll
            for (int r = 0; r < 4; ++r) cp[r * CL + 2 * n + 3 - r - x] = v;
        }
    }
    if (tid < 144) {
        const int r = tid / 36, k = tid % 36, idx = k < 4 ? k : 2 * n + (k - 4);
        if (idx < 4 - r || idx > 2 * n + 3 - r) cp[r * CL + idx] = (bf16_t)0;
    }
    {
        const bf16_t* hb = hyu + tok0;
        for (int i8 = tid; i8 < n; i8 += NTHR) {
            const int idx = 8 * i8, b = idx / n, s = idx % n;
            *(LAS u32x4*)(U + (b * NBLK + (s >> 6)) * 72 + (s & 63)) = *(const u32x4*)(hb + idx);
        }
    }
    __syncthreads();
    unsigned long long hyt0_ = 0; if (HYPROBE == 1) hyt0_ = __builtin_amdgcn_s_memrealtime();
    f32x16 acc[2][NCT];
#pragma unroll
    for (int mt = 0; mt < 2; ++mt)
#pragma unroll
        for (int ct = 0; ct < NCT; ++ct)
#pragma unroll
            for (int i = 0; i < 16; ++i) acc[mt][ct][i] = 0.f;
    const LAS bf16_t* Uw = U + (size_t)w * NBLK * 72;
#pragma unroll 1
    for (int d = -(NBLK - 1); d <= NBLK - 1; ++d) {
        bool act[NCT]; int blk[NCT]; bool val[NCT];
#pragma unroll
        for (int ct = 0; ct < NCT; ++ct) {
            act[ct] = (32 * ct + 31 - d >= 0) && (32 * ct - d <= NBLK - 1);
            const int a = 32 * ct + li; blk[ct] = a - d; val[ct] = (blk[ct] >= 0) && (blk[ct] < NBLK) && (a < NBLK);
        }
#pragma unroll
        for (int ks = 0; ks < 4; ++ks) {
            bf16x8 af[2];
#pragma unroll
            for (int mt = 0; mt < 2; ++mt) {
                const int y0 = n - 1 - 64 * d - (32 * mt + li) + 16 * ks + 8 * h;
                const int r = y0 & 3, m0 = y0 - r + 4;
                const LAS bf16_t* ap = cp + r * CL + m0;
                const u32x2 lo = *(const LAS u32x2*)ap, hi = *(const LAS u32x2*)(ap + 4);
                u32x4 vv; vv.x = lo.x; vv.y = lo.y; vv.z = hi.x; vv.w = hi.y;
                af[mt] = __builtin_bit_cast(bf16x8, vv);
            }
#pragma unroll
            for (int ct = 0; ct < NCT; ++ct) {
                if (act[ct]) {
                    u32x4 bv = {0u, 0u, 0u, 0u};
                    if (val[ct]) bv = *(const LAS u32x4*)(Uw + blk[ct] * 72 + 16 * ks + 8 * h);
                    const bf16x8 bfv = __builtin_bit_cast(bf16x8, bv);
                    acc[0][ct] = MFMA32(af[0], bfv, acc[0][ct]);
                    acc[1][ct] = MFMA32(af[1], bfv, acc[1][ct]);
                }
            }
        }
    }
    if (HYPROBE == 1 && NBLK == 64) { __syncthreads(); if (threadIdx.x == 0) *(LAS unsigned long long*)(lds + LDS_BYTES - 32) += __builtin_amdgcn_s_memrealtime() - hyt0_; }
#pragma unroll
    for (int mt = 0; mt < 2; ++mt)
#pragma unroll
        for (int ct = 0; ct < NCT; ++ct) {
            const int a = 32 * ct + li;
            if (a < NBLK) {
                unsigned tokb = (unsigned)(tok0 + w * n + 64 * a + 32 * mt + 4 * h);
                asm volatile("" : "+v"(tokb));
                const LAS bf16_t* up = Uw + a * 72 + 32 * mt + 4 * h;
                u32x2 xvv[4];
#pragma unroll
                for (int g = 0; g < 4; ++g) xvv[g] = *(const u32x2*)(hyx + tokb + 8u * g);
#pragma unroll
                for (int g = 0; g < 4; ++g) {
                    const unsigned tok = tokb + 8u * g;
                    const u32x2 xv = xvv[g];
                    const u32x2 uv = *(const LAS u32x2*)(up + 8 * g);
                    float o[4];
#pragma unroll
                    for (int j = 0; j < 4; ++j) {
                        const unsigned xw = j < 2 ? xv.x : xv.y, uw = j < 2 ? uv.x : uv.y;
                        const float x0 = (j & 1) ? __uint_as_float(xw & 0xffff0000u) : __uint_as_float(xw << 16);
                        const float uu = (j & 1) ? __uint_as_float(uw & 0xffff0000u) : __uint_as_float(uw << 16);
                        o[j] = (acc[mt][ct][4 * g + j] * inv_norm + uu * dskip) * x0;
                    }
                    u32x2 ov; ov.x = pack2(o[0], o[1]); ov.y = pack2(o[2], o[3]);
                    *(u32x2*)(mix + tok) = ov;
                }
            }
            __builtin_amdgcn_sched_barrier(0);
        }
}

DI void phase_mix(const Params& p, int l, bool need_ctx, LAS unsigned char* lds) {
    const bf16_t* PA = (const bf16_t*)(WSP() + OFF_PA);
    const bf16_t* UPB = (const bf16_t*)(WSP() + OFF_UPB);
    const bf16_t* KR = (const bf16_t*)(WSP() + OFF_KR);
    const bf16_t* HYU = (const bf16_t*)(WSP() + OFF_HYU);
    const bf16_t* HYX = (const bf16_t*)(WSP() + OFF_HYX);
    bf16_t* MIX = (bf16_t*)(WSP() + OFF_R1);
    const f32x2* ROPE = (const f32x2*)(WSP() + OFF_ROPE);
    const int n_items = 256 + 768 + 768 + (need_ctx ? 48 + 48 + 256 : 0);
    LAS float* red = (LAS float*)lds;
    for (int it = obid(); it < n_items; it += gridDim.x) {
        int lin = 0;
        if (it >= 256 && it < 1792) { const int j = it - 256, r = j >> 8, bp = j & 255; lin = ((r * 8 + (bp & 7)) << 5) + (bp >> 3); }
#ifndef MIXSEL
#define MIXSEL 0
#endif
        if ((MIXSEL == 0 || MIXSEL == 1) && (it < 256 || it >= 1888)) {
            const bool isl = it < 256;
            const int c = isl ? it : it - 1888;
            const float* part = isl ? (const float*)(WSP() + OFF_PART) + (size_t)l * 128 * 512 : (const float*)(WSP() + OFF_PARTC) + (size_t)l * 8 * 512;
            const int np = isl ? 128 : 8;
            float s = 0.f;
            const int tq_ = otid();
            if (tq_ < 2 * np) { const int r = tq_ >> 1, hb = tq_ & 1; s = part[(size_t)r * 512 + hb * 256 + c]; }
            s = wave_sum(s);
            __syncthreads();
            if ((tq_ & 63) == 0) red[tq_ >> 6] = s;
            __syncthreads();
            float nrm = 0.f;
#pragma unroll
            for (int i = 0; i < 8; ++i) nrm += red[i];
            __syncthreads();
            const float inv_norm = 1.f / nrm, dskip = INP(26)[l * 256 + c];
            bf16_t* OBT = (bf16_t*)(WSP() + OFF_OBT);
            if (isl) hyena_item<64>(lds, (const bf16_t*)(WSP() + OFF_KF) + ((size_t)l * 256 + c) * 8192, inv_norm, dskip, HYU + (size_t)c * MTOT, HYX + (size_t)c * MTOT, OBT + (size_t)c * MTOT, 0);
            else hyena_item<4>(lds, (const bf16_t*)(WSP() + OFF_KFC) + ((size_t)l * 256 + c) * 512, inv_norm, dskip, HYU + (size_t)c * MTOT, HYX + (size_t)c * MTOT, OBT + (size_t)c * MTOT, MLAT);
        } else if ((MIXSEL == 0 || MIXSEL == 2) && it < 1792 && lin < 768) {
            const int idx = lin, qb = idx & 15, hd = (idx >> 4) % 6, b = idx / 96, hk = hd / 3;
            const size_t tl = (size_t)b * SEQ, tc = (size_t)MLAT + (size_t)b * CTXL;
            attn_item<64>(lds, PA + (tl + qb * 256) * 640 + hd * 64, 640, PA + tc * 640 + 384 + hk * 64, PA + tl * 640 + 384 + hk * 64,
                          PA + tc * 640 + 512 + hk * 64, PA + tl * 640 + 512 + hk * 64, 640, nullptr, nullptr, 68, MIX + (tl + qb * 256) * 1024 + hd * 64, nullptr);
        } else if ((MIXSEL == 0 || MIXSEL == 3) && it < 1792) {
            const int idx = lin - 768, qb = idx & 15, hd = (idx >> 4) % 6, b = idx / 96;
            const size_t tl = (size_t)b * SEQ, tc = (size_t)MLAT + (size_t)b * CTXL;
            attn_item<96>(lds, UPB + (tl + qb * 256) * 1344 + hd * 96, 1344, UPB + tc * 1344 + 576 + hd * 128, UPB + tl * 1344 + 576 + hd * 128,
                          UPB + tc * 1344 + 576 + hd * 128 + 64, UPB + tl * 1344 + 576 + hd * 128 + 64, 1344, KR + tc * 32, KR + tl * 32, 68,
                          MIX + (tl + qb * 256) * 1024 + 640 + hd * 64, ROPE + (size_t)(qb * 256) * 48 + 32);
        } else if ((MIXSEL == 0 || MIXSEL == 2) && it < 1840) {
            const int idx = it - 1792, hd = idx % 6, b = idx / 6, hk = hd / 3;
            const size_t tc = (size_t)MLAT + (size_t)b * CTXL;
            attn_item<64>(lds, PA + tc * 640 + hd * 64, 640, PA + tc * 640 + 384 + hk * 64, PA + tc * 640 + 384 + hk * 64,
                          PA + tc * 640 + 512 + hk * 64, PA + tc * 640 + 512 + hk * 64, 640, nullptr, nullptr, 4, MIX + tc * 1024 + hd * 64, nullptr);
        } else if (MIXSEL == 0 || MIXSEL == 3) {
            const int idx = it - 1840, hd = idx % 6, b = idx / 6;
            const size_t tc = (size_t)MLAT + (size_t)b * CTXL;
            attn_item<96>(lds, UPB + tc * 1344 + hd * 96, 1344, UPB + tc * 1344 + 576 + hd * 128, UPB + tc * 1344 + 576 + hd * 128,
                          UPB + tc * 1344 + 576 + hd * 128 + 64, UPB + tc * 1344 + 576 + hd * 128 + 64, 1344, KR + tc * 32, KR + tc * 32, 4,
                          MIX + tc * 1024 + 640 + hd * 64, nullptr);
        }
        __syncthreads();
    }
}

DI void phase_untranspose(const Params& p, bool need_ctx, LAS unsigned char* lds) {
    const int tid = otid();
    const bf16_t* OBT = (const bf16_t*)(WSP() + OFF_OBT);
    bf16_t* MIX = (bf16_t*)(WSP() + OFF_R1);
    LAS bf16_t* T = (LAS bf16_t*)lds;
    const int ntile = (need_ctx ? MTOT : MLAT) / 64;
    for (int tile = obid(); tile < ntile; tile += gridDim.x) {
        {
            const int ch = tid >> 1, half = tid & 1;
            const bf16_t* src = OBT + (size_t)ch * MTOT + tile * 64 + 32 * half;
#pragma unroll
            for (int q = 0; q < 4; ++q) *(LAS u32x4*)(T + ch * 72 + 32 * half + 8 * q) = *(const u32x4*)(src + 8 * q);
        }
        __syncthreads();
        {
            const int tk = tid >> 3, cg = (tid & 7) * 32;
            unsigned w[16];
#pragma unroll
            for (int j = 0; j < 16; ++j) w[j] = (unsigned)T[(cg + 2 * j) * 72 + tk] | ((unsigned)T[(cg + 2 * j + 1) * 72 + tk] << 16);
            bf16_t* dst = MIX + (size_t)(tile * 64 + tk) * 1024 + 384 + cg;
#pragma unroll
            for (int q = 0; q < 4; ++q) { u32x4 o; o.x = w[4 * q]; o.y = w[4 * q + 1]; o.z = w[4 * q + 2]; o.w = w[4 * q + 3]; *(u32x4*)(dst + 8 * q) = o; }
        }
        __syncthreads();
    }
}

#define XB_TMO      128
#define XB_XCNT(j)  (256  + 64 * (j))
#define XB_XSUB(j)  (1280 + 64 * (j))
#define XB_XGEN(j)  (2304 + 64 * (j))
#define XB_TOP      3328
#define XB_TOPGEN   3392
#define XCD_BAR_WORDS 3456
#define XB_SPIN_CAP (1u << 22)
DI unsigned xb_ld(unsigned* p)              { return __hip_atomic_load(p, __ATOMIC_RELAXED, __HIP_MEMORY_SCOPE_AGENT); }
DI unsigned xb_add(unsigned* p, unsigned v) { return __hip_atomic_fetch_add(p, v, __ATOMIC_RELAXED, __HIP_MEMORY_SCOPE_AGENT); }
DI unsigned xb_xcc_id() { return (unsigned)__builtin_amdgcn_s_getreg((3 << 11) | 20) & 0xFu; }
#define XB_SPIN(cond, bar) do { unsigned _sp = 0; while (cond) { __builtin_amdgcn_s_sleep(1); \
    if ((++_sp & 255u) == 0u) { if (xb_ld(&(bar)[XB_TMO])) break; if (_sp > XB_SPIN_CAP) { atomicAdd(&(bar)[XB_TMO], 1u); break; } } } } while (0)
struct XcdBarrier { unsigned* bar; unsigned x; volatile LAS unsigned* st; };
DI XcdBarrier xcd_barrier_post(unsigned* bar, volatile LAS unsigned* st) {
    XcdBarrier b; b.bar = bar; b.x = xb_xcc_id(); b.st = st;
    if (threadIdx.x == 0) (void)xb_add(&bar[XB_XCNT(b.x)], 1u);
    return b;
}
DI void xcd_barrier_complete(unsigned* bar, unsigned x, unsigned& nloc, unsigned& nx) {
    const unsigned G = gridDim.x * gridDim.y * gridDim.z;
    unsigned sum, cnt, mine, sp = 0u;
    for (;;) {
        sum = 0u; cnt = 0u; mine = 0u;
#pragma unroll
        for (unsigned j = 0; j < 16; ++j) { const unsigned c = xb_ld(&bar[XB_XCNT(j)]); sum += c; cnt += (c > 0u) ? 1u : 0u; mine = (j == x) ? c : mine; }
        if (sum == G) break;
        __builtin_amdgcn_s_sleep(1);
        if ((++sp & 255u) == 0u) { if (xb_ld(&bar[XB_TMO])) break; if (sp > XB_SPIN_CAP) { atomicAdd(&bar[XB_TMO], 1u); break; } }
    }
    nloc = mine > 0u ? mine : 1u; nx = cnt > 0u ? cnt : 1u;
}
DI void xcd_barrier(const XcdBarrier& b) {
    asm volatile("s_waitcnt vmcnt(0)" ::: "memory");
    __syncthreads();
    if (threadIdx.x == 0) {
        unsigned* bar = b.bar;
        __builtin_amdgcn_s_waitcnt(0);
        unsigned nloc = b.st[0], nx = b.st[1];
        if (nloc == 0u) { xcd_barrier_complete(bar, b.x, nloc, nx); b.st[0] = nloc; b.st[1] = nx; }
        const unsigned old = xb_add(&bar[XB_XSUB(b.x)], 1u);
        const unsigned gen = old / nloc;
        if (old + 1u == (gen + 1u) * nloc) {
            __builtin_amdgcn_fence(__ATOMIC_RELEASE, "agent");
            asm volatile("s_waitcnt vmcnt(0)" ::: "memory");
            const unsigned og = xb_add(&bar[XB_TOP], 1u);
            const unsigned tg = og / nx;
            if (og + 1u == (tg + 1u) * nx) xb_add(&bar[XB_TOPGEN], 1u);
            else XB_SPIN(xb_ld(&bar[XB_TOPGEN]) == tg, bar);
            __builtin_amdgcn_fence(__ATOMIC_ACQUIRE, "agent");
            xb_add(&bar[XB_XGEN(b.x)], 1u);
            asm volatile("s_waitcnt vmcnt(0)" ::: "memory");
        } else {
            XB_SPIN(xb_ld(&bar[XB_XGEN(b.x)]) == gen, bar);
            __builtin_amdgcn_fence(__ATOMIC_ACQUIRE, "agent");
            asm volatile("s_waitcnt vmcnt(0)" ::: "memory");
        }
    }
    __syncthreads();
}

__global__ void __launch_bounds__(NTHR) mega(Params p) {
    extern __shared__ __attribute__((aligned(16))) unsigned char lds_raw[];
    LAS unsigned char* lds = (LAS unsigned char*)lds_raw;
    cg::grid_group grid = cg::this_grid();
    int ph = 0;
#ifndef ONLY
#define ONLY -1
#endif
#ifndef TPROBE
#define TPROBE -1
#endif
#define PHASE(kind, body) do { if ((ONLY < 0 || ONLY == (kind)) && ph >= p.ph_lo && ph < p.ph_hi) { \
        unsigned long long t0_ = 0; if (TPROBE == (kind)) t0_ = __builtin_amdgcn_s_memrealtime(); \
        { unsigned char* ws = WSP(); body; } \
        if (ph + 1 < p.ph_hi) { if (ph == 0) grid.sync(); else xcd_barrier(xbar); } \
        if (TPROBE == (kind)) tprobe += __builtin_amdgcn_s_memrealtime() - t0_; } ++ph; } while (0)
    unsigned long long tprobe = 0;
    {
        volatile LAS unsigned* st = (volatile LAS unsigned*)(lds + LDS_BYTES - 16);
        if (threadIdx.x == 0) { st[0] = 0u; st[1] = 0u; *(LAS unsigned long long*)(lds + LDS_BYTES - 32) = 0ull; }
        __syncthreads();
    }
    XcdBarrier xbar = xcd_barrier_post((unsigned*)(WSP() + OFF_BAR), (volatile LAS unsigned*)(lds + LDS_BYTES - 16));
#ifndef DUP_P0
#define DUP_P0 1
#endif
#pragma unroll 1
    for (int rep = 0; rep < DUP_P0; ++rep) {
    PHASE(0, phase_p0a(p, lds));
    PHASE(1, phase_ln(p, MTOT, true, nullptr, nullptr, true, 0, 0, 1, false));
    }
#ifndef XSYNC
#define XSYNC 0
#endif
#pragma unroll 1
    for (int rep = 0; rep < XSYNC; ++rep) grid.sync();
#pragma unroll 1
    for (int l = 0; l < 2; ++l) {
#pragma unroll 1
        for (int s = 0; s < 3; ++s) {
#define X ((float*)(ws + OFF_X))
#define H ((bf16_t*)(ws + OFF_R1))
#define ACT ((bf16_t*)(ws + OFF_R2))
#define W (ws + OFF_W + (size_t)l * SZ_WL)
#define mod ((const float*)(ws + OFF_MOD) + (size_t)l * 9 * 9216)
            const int Mrows = (l == 1 && s == 2) ? MLAT : MTOT;
            if (s != 1) {
#define wgu ((const bf16_t*)(W + (s == 0 ? WO_GU1 : WO_GU2)))
#define wd ((const bf16_t*)(W + (s == 0 ? WO_D1 : WO_D2)))
#ifndef DUP_GU
#define DUP_GU 1
#endif
#ifndef DUP_MIX
#define DUP_MIX 1
#endif
#pragma unroll 1
                for (int rep = 0; rep < DUP_GU; ++rep)
                PHASE(2, gm::gemm_phase(lds, H, 1024, wgu, 1024, Mrows, 5632, 1024, gm::EpiSwiglu{ACT}));
                const bool last = (l == 1 && s == 2);
                const bool dm = !last;
                const int lm = (s == 0) ? l : l + 1;
                const float* lg = INP(10) + (size_t)(l * 3 + s) * D; const float* lb = INP(11) + (size_t)(l * 3 + s) * D;
#define er (gm::EpiResid{X, mod + (s == 0 ? 2 : 8) * 1024, 0.5f})
                PHASE(3, gm::gemm_phase(lds, ACT, DFF, wd, DFF, MLAT, 1024, DFF, er));
                if (Mrows == MTOT) {
                    PHASE(9, { if (obid() < 32) gm::gemm_phase(lds, ACT, DFF, wd, DFF, MCTX, 1024, DFF, er, MLAT / 256, 0, 32);
                               else phase_ln(p, MLAT, false, lg, lb, dm, dm ? lm : 0, s == 0 ? 3 : 0, s == 0 ? 4 : 1, last, 0, 32, (int)gridDim.x - 32); });
                    PHASE(1, phase_ln(p, MTOT, false, lg, lb, dm, dm ? lm : 0, s == 0 ? 3 : 0, s == 0 ? 4 : 1, last, MLAT));
                } else {
                    PHASE(1, phase_ln(p, MLAT, false, lg, lb, dm, dm ? lm : 0, s == 0 ? 3 : 0, s == 0 ? 4 : 1, last));
                }
            } else {
#ifndef DUP_WP
#define DUP_WP 1
#endif
#pragma unroll 1
                for (int rep = 0; rep < DUP_WP; ++rep) {
                PHASE(4, gm::gemm_phase(lds, H, 1024, (const bf16_t*)(W + WO_IN), 1024, MTOT, 2048, 1024,
                                     gm::EpiWin{(bf16_t*)(ws + OFF_PA), (bf16_t*)(ws + OFF_PBB), (bf16_t*)(ws + OFF_PC)}));
                PHASE(5, phase_post(p, l, lds));
                }
                PHASE(6, gm::gemm_phase(lds, (const bf16_t*)(ws + OFF_R1), 384, (const bf16_t*)(W + WO_UP), 384, MTOT, 1536, 384,
                                     gm::EpiUp{(bf16_t*)(ws + OFF_UPB), 0.10206207261596577f * LOG2E}));
#pragma unroll 1
                for (int rep = 0; rep < DUP_MIX; ++rep)
{                 PHASE(7, phase_mix(p, l, l == 0, lds)); }
                PHASE(10, phase_untranspose(p, l == 0, lds));
                const float* lg = INP(10) + (size_t)(l * 3 + 1) * D; const float* lb = INP(11) + (size_t)(l * 3 + 1) * D;
#undef er
#define er (gm::EpiResid{X, mod + 5 * 1024, 1.0f})
#define MIXp ((const bf16_t*)(ws + OFF_R1))
#define wo ((const bf16_t*)(W + WO_OUT))
                PHASE(8, gm::gemm_phase(lds, MIXp, 1024, wo, 1024, MLAT, 1024, 1024, er));
                if (l == 0) {
                    PHASE(9, { if (obid() < 32) gm::gemm_phase(lds, MIXp, 1024, wo, 1024, MCTX, 1024, 1024, er, MLAT / 256, 0, 32);
                               else phase_ln(p, MLAT, false, lg, lb, true, l, 6, 7, false, 0, 32, (int)gridDim.x - 32); });
                    PHASE(1, phase_ln(p, MTOT, false, lg, lb, true, l, 6, 7, false, MLAT));
                } else {
                    PHASE(1, phase_ln(p, MLAT, false, lg, lb, true, l, 6, 7, false));
                }
            }
        }
    }
    if (HYPROBE || PPROBE) tprobe = *(LAS unsigned long long*)(lds + LDS_BYTES - 32);
    if (TPROBE >= 0 || HYPROBE || PPROBE) {
        xcd_barrier(xbar);
        if (obid() == 0) {
            const unsigned m = (unsigned)(tprobe / 10ull);
            for (unsigned i = threadIdx.x; i < m && i < 200000u; i += NTHR) OUTP()[(size_t)i * 131u] += 0.1f;
        }
    }
}

constexpr int NPHASES = 1 << 20;

extern "C" void kernel_launch(void* const* d_in, const int* in_sizes, int n_in, void* d_out, int out_size, void* d_ws, size_t ws_size, hipStream_t stream) {
    static int grid = 0;
    if (grid == 0) {
        if (n_in != 31 || ws_size < WS_END) { fprintf(stderr, "kernel_launch: unexpected n_in %d or ws_size %zu (< %zu)\n", n_in, ws_size, (size_t)WS_END); grid = -1; return; }
        int dev = 0, cus = 0, per_cu = 0;
        hipGetDevice(&dev);
        hipDeviceGetAttribute(&cus, hipDeviceAttributeMultiprocessorCount, dev);
        if (hipFuncSetAttribute((const void*)mega, hipFuncAttributeMaxDynamicSharedMemorySize, LDS_BYTES) != hipSuccess) { fprintf(stderr, "kernel_launch: hipFuncSetAttribute failed\n"); grid = -1; return; }
        if (hipOccupancyMaxActiveBlocksPerMultiprocessor(&per_cu, (const void*)mega, NTHR, LDS_BYTES) != hipSuccess || per_cu < 1) { fprintf(stderr, "kernel_launch: occupancy query failed (%d)\n", per_cu); per_cu = 1; }
        (void)hipGetLastError();
        grid = cus * (per_cu > 1 ? 1 : per_cu);
    }
    if (grid < 0) return;
    Params prm{};
    for (int i = 0; i < 31; ++i) prm.in[i] = (const float*)d_in[i];
    prm.out = (float*)d_out; prm.ws = (unsigned char*)d_ws;
    prm.ph_lo = 0; prm.ph_hi = NPHASES;
    (void)hipMemsetAsync((unsigned char*)d_ws + OFF_BAR, 0, 4096 * 4, stream);
    void* args[] = {&prm};
    hipError_t e = hipLaunchCooperativeKernel((const void*)mega, dim3(grid), dim3(NTHR), args, LDS_BYTES, stream);
    if (e != hipSuccess) fprintf(stderr, "kernel_launch: cooperative launch failed: %s (grid %d)\n", hipGetErrorString(e), grid);
}
```

```cpp
#include <hip/hip_runtime.h>
#include <hip/hip_cooperative_groups.h>
#include <cstdio>
#include <cstdint>
namespace cg = cooperative_groups;

#define LAS __attribute__((address_space(3)))
#define DI __device__ __forceinline__
typedef unsigned short bf16_t;
typedef short bf16x8 __attribute__((ext_vector_type(8)));
typedef short s16x4 __attribute__((ext_vector_type(4)));
typedef float f32x2 __attribute__((ext_vector_type(2)));
typedef float f32x4 __attribute__((ext_vector_type(4)));
typedef float f32x16 __attribute__((ext_vector_type(16)));
typedef unsigned u32x2 __attribute__((ext_vector_type(2)));
typedef unsigned u32x4 __attribute__((ext_vector_type(4)));
typedef __bf16 bf2_t __attribute__((ext_vector_type(2)));

constexpr int D = 1024, NB = 8, SEQ = 4096, CTXL = 256, DFF = 2816;
constexpr int MLAT = NB * SEQ, MCTX = NB * CTXL, MTOT = MLAT + MCTX;
constexpr float EPS = 1e-6f, ALPHA = 1.41421356237309515f, LOG2E = 1.44269504088896341f;
constexpr int NTHR = 512;
constexpr int LDS_BYTES = 147456;

constexpr size_t SZ_X = (size_t)MTOT * D * 4;
constexpr size_t WO_GU1 = 0, WO_D1 = WO_GU1 + (size_t)5632 * 1024 * 2, WO_GU2 = WO_D1 + (size_t)1024 * 2816 * 2, WO_D2 = WO_GU2 + (size_t)5632 * 1024 * 2,
                 WO_IN = WO_D2 + (size_t)1024 * 2816 * 2, WO_OUT = WO_IN + (size_t)2048 * 1024 * 2, WO_UP = WO_OUT + (size_t)1024 * 1024 * 2, SZ_WL = WO_UP + (size_t)1536 * 384 * 2;
constexpr size_t OFF_X = 0;
constexpr size_t OFF_W = OFF_X + SZ_X;
constexpr size_t OFF_MOD = OFF_W + 2 * SZ_WL;
constexpr size_t OFF_KF = OFF_MOD + (size_t)2 * 9 * 9216 * 4;
constexpr size_t OFF_KFC = OFF_KF + (size_t)2 * 256 * 8192 * 2;
constexpr size_t OFF_PART = OFF_KFC + (size_t)2 * 256 * 512 * 2;
constexpr size_t OFF_PARTC = OFF_PART + (size_t)2 * 128 * 512 * 4;
constexpr size_t OFF_ROPE = OFF_PARTC + (size_t)2 * 8 * 512 * 4;
constexpr size_t OFF_R1 = OFF_ROPE + (size_t)4096 * 48 * 8;
constexpr size_t SZ_R1 = (size_t)MTOT * 1024 * 2;
constexpr size_t OFF_R2 = OFF_R1 + SZ_R1;
constexpr size_t SZ_R2 = (size_t)MTOT * DFF * 2;
constexpr size_t OFF_PA = OFF_R2;
constexpr size_t OFF_HYU = OFF_PA + (size_t)MTOT * 640 * 2;
constexpr size_t OFF_HYX = OFF_HYU + (size_t)MTOT * 256 * 2;
constexpr size_t OFF_KR = OFF_HYX + (size_t)MTOT * 256 * 2;
constexpr size_t OFF_PBB = OFF_KR + (size_t)MTOT * 32 * 2;
constexpr size_t OFF_PC = OFF_PBB + (size_t)MTOT * 768 * 2;
constexpr size_t OFF_UPB = OFF_PBB;
constexpr size_t OFF_OBT = OFF_UPB + (size_t)MTOT * 1344 * 2;
constexpr size_t OFF_BAR = OFF_R2 + SZ_R2;
constexpr size_t WS_END = OFF_BAR + (size_t)4096 * 4;
static_assert(OFF_PC + (size_t)MTOT * 416 * 2 <= WS_END, "R2 overflow");
static_assert(OFF_OBT + (size_t)MTOT * 256 * 2 <= OFF_R2 + SZ_R2, "R2 overflow");
static_assert(WS_END <= (size_t)536870912, "workspace too large");

struct Params {
    const float* in[31];
    float* out;
    unsigned char* ws;
    int ph_lo, ph_hi;
};


typedef __attribute__((address_space(4))) const unsigned char* kargp_t;
DI kargp_t karg_base() { kargp_t k = (kargp_t)__builtin_amdgcn_kernarg_segment_ptr(); asm volatile("" : "+s"(k)); return k; }
#define GAS __attribute__((address_space(1)))
DI const float* INP(int i) { const float* q = *(const float* __attribute__((address_space(4))) const*)(karg_base() + 8 * i); return q; }
DI float* OUTP() { float* q = *(float* __attribute__((address_space(4))) const*)(karg_base() + 8 * 31); return q; }
DI unsigned char* WSP() { unsigned char* q = *(unsigned char* __attribute__((address_space(4))) const*)(karg_base() + 8 * 32); return q; }

DI float bf2f(bf16_t b) { return __uint_as_float(((unsigned)b) << 16); }
DI unsigned pack2(float a, float b) { f32x2 v = {a, b}; bf2_t r = __builtin_convertvector(v, bf2_t); return __builtin_bit_cast(unsigned, r); }
DI bf16_t f2bf(float a) { return (bf16_t)(pack2(a, 0.f) & 0xffffu); }
DI float wave_sum(float v) {
#pragma unroll
    for (int o = 32; o > 0; o >>= 1) v += __shfl_xor(v, o);
    return v;
}
DI float fast_exp2(float x) { return __builtin_amdgcn_exp2f(x); }
DI int otid() { int t = threadIdx.x; asm volatile("" : "+v"(t)); return t; }
DI int obid() { int t = blockIdx.x; asm volatile("" : "+s"(t)); return t; }
DI int crow(int reg, int h) { return (reg & 3) + 8 * (reg >> 2) + 4 * h; }
#define MFMA32(a, b, c) __builtin_amdgcn_mfma_f32_32x32x16_bf16((a), (b), (c), 0, 0, 0)

DI void conv_item(const Params& p, int it, LAS unsigned char* lds) {
    LAS float* tile = (LAS float*)lds;
    const int tid = otid();
    const int l = it / 2568; int r = it % 2568;
    int mat, K; size_t woff;
    if (r < 704) { mat = 0; K = 1024; woff = WO_GU1; }
    else if (r < 1056) { r -= 704; mat = 1; K = 2816; woff = WO_D1; }
    else if (r < 1760) { r -= 1056; mat = 2; K = 1024; woff = WO_GU2; }
    else if (r < 2112) { r -= 1760; mat = 3; K = 2816; woff = WO_D2; }
    else if (r < 2368) { r -= 2112; mat = 4; K = 1024; woff = WO_IN; }
    else if (r < 2496) { r -= 2368; mat = 5; K = 1024; woff = WO_OUT; }
    else { r -= 2496; mat = 6; K = 384; woff = WO_UP; }
    const int nK = K / 64, tn = r / nK, tk = r % nK, n0 = tn * 128, k0 = tk * 64;
    bf16_t* dst = (bf16_t*)(WSP() + OFF_W + (size_t)l * SZ_WL + woff);
    {
        const int kk = tid >> 7, n = n0 + (tid & 127);
        const float* sp; const float* sc = nullptr; int ld, klo = 0, khi = K; bool zero = false;
        if (mat == 0 || mat == 2) {
            const int tl_ = n >> 8, c_ = n & 255, bj_ = c_ >> 7, wc_ = (c_ >> 5) & 3, t_ = (c_ >> 4) & 1, fq_ = (c_ >> 2) & 3, j_ = c_ & 3;
            const int unit = tl_ * 128 + wc_ * 32 + fq_ * 8 + bj_ * 4 + j_, col = t_ * 2816 + unit;
            sp = (mat == 0 ? INP(6) : INP(8)) + (size_t)l * 1024 * 5632 + col; ld = 5632;
        } else if (mat == 1 || mat == 3) {
            const int an = (n & ~31) + 8 * ((n & 15) >> 2) + 4 * ((n >> 4) & 1) + (n & 3);
            sp = (mat == 1 ? INP(7) : INP(9)) + (size_t)l * 2816 * 1024 + an; ld = 1024;
        } else if (mat == 4) {
            const int an = (n & ~31) + 8 * ((n & 15) >> 2) + 4 * ((n >> 4) & 1) + (n & 3);
            zero = an >= 1824; sp = INP(12) + (size_t)l * 1024 * 1824 + (zero ? 0 : an); ld = 1824;
        } else if (mat == 5) {
            const int an = (n & ~31) + 8 * ((n & 15) >> 2) + 4 * ((n >> 4) & 1) + (n & 3);
            sp = INP(13) + (size_t)l * 1024 * 1024 + an; ld = 1024;
        } else {
            const int an = (n & ~31) + 8 * ((n & 15) >> 2) + 4 * ((n >> 4) & 1) + (n & 3);
            if (an < 576) { sp = INP(29) + (size_t)l * 256 * 576 + an; ld = 576; khi = 256; sc = INP(27) + l * 256; }
            else if (an < 1344) { sp = INP(30) + (size_t)l * 128 * 768 + (an - 576); ld = 768; klo = 256; sc = INP(28) + l * 128; }
            else { zero = true; sp = INP(29); ld = 0; sc = INP(27); }
        }
        const bool has_sc = (mat == 6);
        float v[16];
#pragma unroll
        for (int ps = 0; ps < 16; ++ps) {
            const int k = k0 + ps * 4 + kk;
            const bool valid = !zero && k >= klo && k < khi;
            const int idx = valid ? k - klo : 0;
            float x = sp[(size_t)idx * ld];
            if (has_sc) x *= sc[idx];
            v[ps] = valid ? x : 0.f;
        }
#pragma unroll
        for (int ps = 0; ps < 16; ++ps) tile[(ps * 4 + kk) * 129 + (tid & 127)] = v[ps];
    }
    __syncthreads();
    {
        const int nl = tid >> 2, kc = (tid & 3) * 16;
#pragma unroll
        for (int hh = 0; hh < 2; ++hh) {
            const int kb = kc + hh * 8;
            u32x4 o;
            o.x = pack2(tile[(kb + 0) * 129 + nl], tile[(kb + 1) * 129 + nl]);
            o.y = pack2(tile[(kb + 2) * 129 + nl], tile[(kb + 3) * 129 + nl]);
            o.z = pack2(tile[(kb + 4) * 129 + nl], tile[(kb + 5) * 129 + nl]);
            o.w = pack2(tile[(kb + 6) * 129 + nl], tile[(kb + 7) * 129 + nl]);
            *(u32x4*)(dst + (size_t)(n0 + nl) * K + k0 + kb) = o;
        }
    }
}

DI void mod_item(const Params& p, int it, LAS unsigned char* lds) {
    LAS float* s = (LAS float*)lds;
    LAS float* red = s + 12 * 1024;
    const int tid = otid();
    const int l = it / 144, jb = it % 144, j0 = jb * 64;
    {
        const float* cvec = INP(1); const float* cctx = INP(3);
        float vv[18];
#pragma unroll
        for (int q = 0; q < 18; ++q) { const int idx = tid + q * NTHR, r = idx >> 10, k = idx & 1023; vv[q] = r < 8 ? cvec[r * 1024 + k] : cctx[k]; }
#pragma unroll
        for (int q = 0; q < 18; ++q) { const int idx = tid + q * NTHR, r = idx >> 10, k = idx & 1023; s[k * 12 + r] = vv[q] / (1.f + __expf(-vv[q])); }
    }
    __syncthreads();
    const int jc = tid & 63, kg = tid >> 6;
    const float* w = INP(4) + (size_t)l * 1024 * 9216 + j0 + jc;
    float acc[9];
#pragma unroll
    for (int r = 0; r < 9; ++r) acc[r] = 0.f;
#pragma unroll 16
    for (int k = kg * 128; k < kg * 128 + 128; ++k) {
        const float wv = w[(size_t)k * 9216];
        const f32x4 s0 = *(const LAS f32x4*)(s + k * 12), s1 = *(const LAS f32x4*)(s + k * 12 + 4); const float s8 = s[k * 12 + 8];
        acc[0] += s0[0] * wv; acc[1] += s0[1] * wv; acc[2] += s0[2] * wv; acc[3] += s0[3] * wv;
        acc[4] += s1[0] * wv; acc[5] += s1[1] * wv; acc[6] += s1[2] * wv; acc[7] += s1[3] * wv; acc[8] += s8 * wv;
    }
#pragma unroll
    for (int r = 0; r < 9; ++r) red[(kg * 9 + r) * 64 + jc] = acc[r];
    __syncthreads();
    float* mod = (float*)(WSP() + OFF_MOD) + (size_t)l * 9 * 9216;
    const float* adab = INP(5);
    for (int idx = tid; idx < 9 * 64; idx += NTHR) {
        const int r = idx >> 6, c = idx & 63;
        float v = adab[l * 9216 + j0 + c];
#pragma unroll
        for (int g = 0; g < 8; ++g) v += red[(g * 9 + r) * 64 + c];
        mod[(size_t)r * 9216 + j0 + c] = v;
    }
}

DI void filt_item(const Params& p, int it, LAS unsigned char* lds) {
    const int tid = otid();
    const int l = it / 136; int r = it % 136;
    const int which = r < 128 ? 0 : 1; if (which) r -= 128;
    const int n = which ? 256 : 4096, t0 = r * 32;
    LAS float* z = (LAS float*)lds;
    LAS float* hA = z + 32 * 33;
    LAS float* hB = hA + 32 * 64;
    LAS bf16_t* ot = (LAS bf16_t*)(hB + 32 * 64);
    for (int idx = tid; idx < 32 * 33; idx += NTHR) {
        const int tt = idx / 33, e = idx % 33, ti = t0 + tt;
        float v;
        if (e == 0) v = (float)ti / (float)(n - 1);
        else {
            const int j = (e - 1) & 15;
            const float f = 1e-4f + (float)j * ((15.f - 1e-4f) / 15.f);
            const float w = 6.283185307179586f * (float)ti / (float)n;
            const float a = f * w;
            v = e <= 16 ? cosf(a) : -sinf(a);
        }
        z[idx] = v;
    }
    __syncthreads();
    const float* W1 = INP(18) + l * 33 * 64; const float* B1 = INP(19) + l * 64;
    const float* W2 = INP(20) + l * 64 * 64; const float* B2 = INP(21) + l * 64;
    const float* W3 = INP(22) + l * 64 * 64; const float* B3 = INP(23) + l * 64;
    const float* W4 = INP(24) + l * 64 * 512; const float* FR = INP(25) + l * 64;
    {
        const int j = tid & 63, t8 = tid >> 6;
        float a[4];
#pragma unroll
        for (int q = 0; q < 4; ++q) a[q] = B1[j];
#pragma unroll 11
        for (int e = 0; e < 33; ++e) { const float wv = W1[e * 64 + j];
#pragma unroll
            for (int q = 0; q < 4; ++q) a[q] += z[(t8 + 8 * q) * 33 + e] * wv; }
        const float fr = FR[j];
#pragma unroll
        for (int q = 0; q < 4; ++q) hA[(t8 + 8 * q) * 64 + j] = sinf(fr * a[q]);
        __syncthreads();
#pragma unroll
        for (int q = 0; q < 4; ++q) a[q] = B2[j];
#pragma unroll 16
        for (int e = 0; e < 64; ++e) { const float wv = W2[e * 64 + j];
#pragma unroll
            for (int q = 0; q < 4; ++q) a[q] += hA[(t8 + 8 * q) * 64 + e] * wv; }
#pragma unroll
        for (int q = 0; q < 4; ++q) hB[(t8 + 8 * q) * 64 + j] = sinf(fr * a[q]);
        __syncthreads();
#pragma unroll
        for (int q = 0; q < 4; ++q) a[q] = B3[j];
#pragma unroll 16
        for (int e = 0; e < 64; ++e) { const float wv = W3[e * 64 + j];
#pragma unroll
            for (int q = 0; q < 4; ++q) a[q] += hB[(t8 + 8 * q) * 64 + e] * wv; }
#pragma unroll
        for (int q = 0; q < 4; ++q) hA[(t8 + 8 * q) * 64 + j] = sinf(fr * a[q]);
        __syncthreads();
    }
    {
        const int col = tid, c = col & 255;
        const float a0 = -3.0701134573253942f, a1 = -15.350567286626972f;
        const float delta = fabsf(a0 + (float)c * ((a1 - a0) / 255.f));
        float part = 0.f;
        float w4r[64];
#pragma unroll
        for (int e = 0; e < 64; ++e) w4r[e] = W4[e * 512 + col];
#pragma unroll 1
        for (int tt = 0; tt < 32; ++tt) {
            float a = 0.f;
#pragma unroll
            for (int e = 0; e < 64; e += 4) { const f32x4 hv = *(const LAS f32x4*)(hA + tt * 64 + e);
                a += hv[0] * w4r[e] + hv[1] * w4r[e + 1] + hv[2] * w4r[e + 2] + hv[3] * w4r[e + 3]; }
            const int ti = t0 + tt;
            const float tl = (float)ti / (float)(n - 1);
            float v = a * __expf(-tl * delta);
            if (col >= 256 && ti == 0) v = 0.f;
            part += fabsf(v);
            ot[col * 32 + tt] = f2bf(v);
        }
        float* pp = which ? (float*)(WSP() + OFF_PARTC) + ((size_t)l * 8 + r) * 512 : (float*)(WSP() + OFF_PART) + ((size_t)l * 128 + r) * 512;
        pp[col] = part;
    }
    __syncthreads();
    bf16_t* kf = which ? (bf16_t*)(WSP() + OFF_KFC) + (size_t)l * 256 * 512 : (bf16_t*)(WSP() + OFF_KF) + (size_t)l * 256 * 8192;
    for (int idx = tid; idx < 512 * 32; idx += NTHR) {
        const int col = idx >> 5, tt = idx & 31, ti = t0 + tt, c = col & 255;
        const bf16_t v = ot[col * 32 + tt];
        if (col < 256) kf[(size_t)c * (2 * n) + n + ti] = v;
        else if (ti == 0) kf[(size_t)c * (2 * n)] = 0;
        else kf[(size_t)c * (2 * n) + n - ti] = v;
    }
}

DI void rope_item(const Params& p, int it) {
    const int e = it * NTHR + otid();
    const int pos = e / 48, a = e % 48;
    const int row = pos >> 6, col = pos & 63;
    float inv, coord;
    if (a < 32) { const int f = a & 15; inv = powf(10000.f, -(float)f / 16.f); coord = (float)(a < 16 ? row : col); }
    else { const int a2 = a - 32, f = a2 & 7; inv = powf(10000.f, -(float)f / 8.f); coord = (float)(a2 < 8 ? row : col); }
    const float ang = coord * inv;
    f32x2 cs = {cosf(ang), sinf(ang)};
    ((f32x2*)(WSP() + OFF_ROPE))[e] = cs;
}

#ifndef PPROBE
#define PPROBE 0
#endif
DI void phase_p0a(const Params& p, LAS unsigned char* lds) {
    constexpr int NMODI = 288, NFILT = 272, NROPE = 384, NCONV = 2 * 2568;
    constexpr int TOTAL = NMODI + NFILT + NROPE + NCONV;
    for (int it = obid(); it < TOTAL; it += gridDim.x) {
        unsigned long long pt0_ = 0; if (PPROBE) pt0_ = __builtin_amdgcn_s_memrealtime();
        if (it < NMODI) mod_item(p, it, lds);
        else if (it < NMODI + NFILT) filt_item(p, it - NMODI, lds);
        else if (it < NMODI + NFILT + NROPE) rope_item(p, it - NMODI - NFILT);
        else conv_item(p, it - NMODI - NFILT - NROPE, lds);
        __syncthreads();
        if (PPROBE) { const int ty = it < NMODI ? 1 : (it < NMODI + NFILT ? 2 : (it < NMODI + NFILT + NROPE ? 4 : 8));
            if ((PPROBE & ty) && threadIdx.x == 0) *(LAS unsigned long long*)(lds + LDS_BYTES - 32) += __builtin_amdgcn_s_memrealtime() - pt0_; }
    }
}

DI void phase_ln(const Params& p, int M, bool first, const float* g, const float* bta, bool do_mod, int lmod, int i_shift, int i_scale, bool write_out, int row0 = 0, int vb0 = 0, int vG = 0, const bf16_t* Yd = nullptr) {
    const int tid_ = otid(); const int lane = tid_ & 63, wv = tid_ >> 6;
    float* X = (float*)(WSP() + OFF_X);
    bf16_t* H = (bf16_t*)(WSP() + OFF_R1);
    const float* mod = (const float*)(WSP() + OFF_MOD) + (size_t)lmod * 9 * 9216;
    const int Gl = vG > 0 ? vG : (int)gridDim.x, vbl = obid() - vb0;
    if (vbl < 0 || vbl >= Gl) return;
    const float* xin = first ? INP(0) : nullptr; const float* cin = first ? INP(2) : nullptr;
#define LN_LOAD(r, dst) do { const float* src_ = first ? ((r) < MLAT ? xin + (size_t)(r) * D : cin + (size_t)((r) - MLAT) * D) : X + (size_t)(r) * D; \
        _Pragma("unroll") for (int q = 0; q < 4; ++q) dst[q] = *(const f32x4*)(src_ + q * 256 + lane * 4); \
        if (Yd != nullptr) { _Pragma("unroll") for (int q = 0; q < 4; ++q) { const u32x2 y_ = *(const u32x2*)(Yd + (size_t)(r) * D + q * 256 + lane * 4); \
            dst[q] = dst[q] + (f32x4){__uint_as_float(y_.x << 16), __uint_as_float(y_.x & 0xffff0000u), __uint_as_float(y_.y << 16), __uint_as_float(y_.y & 0xffff0000u)}; } } } while (0)
    const int rstep = Gl * 8;
    f32x4 gg4[4], bb4[4];
#pragma unroll
    for (int q = 0; q < 4; ++q) { gg4[q] = (f32x4){1.f, 1.f, 1.f, 1.f}; bb4[q] = (f32x4){0.f, 0.f, 0.f, 0.f}; }
    if (!first) {
#pragma unroll
        for (int q = 0; q < 4; ++q) { gg4[q] = *(const f32x4*)(g + q * 256 + lane * 4); bb4[q] = *(const f32x4*)(bta + q * 256 + lane * 4); }
    }
    f32x4 v[4], vn[4];
    { const int r0_ = row0 + vbl * 8 + wv; if (r0_ < M) LN_LOAD(r0_, v); }
    for (int row = row0 + vbl * 8 + wv; row < M; row += rstep) {
        const bool more = row + rstep < M;
        if (more) LN_LOAD(row + rstep, vn);
        f32x4 sc4[4], sh4[4];
        if (do_mod) {
            const int bi_ = row < MLAT ? (row >> 12) : 8;
            const float* sh_ = mod + (size_t)bi_ * 9216 + i_shift * 1024; const float* sc_ = mod + (size_t)bi_ * 9216 + i_scale * 1024;
#pragma unroll
            for (int q = 0; q < 4; ++q) { sc4[q] = *(const f32x4*)(sc_ + q * 256 + lane * 4); sh4[q] = *(const f32x4*)(sh_ + q * 256 + lane * 4); }
        }
        if (!first) {
            float s = 0.f;
#pragma unroll
            for (int q = 0; q < 4; ++q) s += (v[q][0] + v[q][1]) + (v[q][2] + v[q][3]);
            const float mu = wave_sum(s) * (1.f / 1024.f);
            float ss = 0.f;
#pragma unroll
            for (int q = 0; q < 4; ++q) { const f32x4 d = v[q] - mu; ss += (d[0] * d[0] + d[1] * d[1]) + (d[2] * d[2] + d[3] * d[3]); }
            const float rstd = rsqrtf(wave_sum(ss) * (1.f / 1024.f) + EPS);
#pragma unroll
            for (int q = 0; q < 4; ++q) {
                v[q] = (v[q] - mu) * rstd * gg4[q] + bb4[q];
            }
        }
#pragma unroll
        for (int q = 0; q < 4; ++q) if (!write_out) *(f32x4*)(X + (size_t)row * D + q * 256 + lane * 4) = ALPHA * v[q];
        if (write_out && row < MLAT) {
#pragma unroll
            for (int q = 0; q < 4; ++q) *(f32x4*)(OUTP() + (size_t)row * D + q * 256 + lane * 4) = v[q];
        }
        if (do_mod) {
            float s = 0.f;
#pragma unroll
            for (int q = 0; q < 4; ++q) s += (v[q][0] + v[q][1]) + (v[q][2] + v[q][3]);
            const float mu = wave_sum(s) * (1.f / 1024.f);
            float ss = 0.f;
#pragma unroll
            for (int q = 0; q < 4; ++q) { const f32x4 d = v[q] - mu; ss += (d[0] * d[0] + d[1] * d[1]) + (d[2] * d[2] + d[3] * d[3]); }
            const float rstd = rsqrtf(wave_sum(ss) * (1.f / 1024.f) + EPS);
#pragma unroll
            for (int q = 0; q < 4; ++q) {
                const f32x4 s4 = sc4[q], h4 = sh4[q];
                const f32x4 o = (v[q] - mu) * rstd * (1.f + s4) + h4;
                u32x2 w; w.x = pack2(o[0], o[1]); w.y = pack2(o[2], o[3]);
                *(u32x2*)(H + (size_t)row * D + q * 256 + lane * 4) = w;
            }
        }
        if (more) {
#pragma unroll
            for (int q = 0; q < 4; ++q) v[q] = vn[q];
        }
    }
#undef LN_LOAD
}

namespace gm {
constexpr int BM = 256, BK = 64, HALF = 128, HTB = HALF * BK * 2, NXCD = 8, WGM = 8;
DI int lds_byte(int r, int c) { const int st = (r >> 4) * 2 + (c >> 5), rr = r & 15, cc = c & 31, ob = rr * 64 + cc * 2; return st * 1024 + (ob ^ (((ob >> 9) & 1) << 5)); }
DI void stage_rc(int b, int& R, int& C) { const int st = b / 1024, sb = b % 1024, swz = sb ^ (((sb >> 9) & 1) << 5); R = (st >> 1) * 16 + swz / 64; C = (st & 1) * 32 + (swz % 64) / 2; }

struct EpiSwiglu {
    static constexpr bool SPLITK = false;
    bf16_t* act;
    DI void operator()(const f32x4 (&acc)[2][2][4][2], int pm, int pn, int wr, int wc, int fr, int fq, bool) const {
        const int unit0 = pn * 128 + wc * 32 + fq * 8;
#pragma unroll
        for (int ai = 0; ai < 2; ++ai)
#pragma unroll
            for (int m = 0; m < 4; ++m) {
                const int row = pm * 256 + ai * 128 + wr * 64 + m * 16 + fr;
                float o[8];
#pragma unroll
                for (int bj = 0; bj < 2; ++bj) {
                    const f32x4 gt = acc[ai][bj][m][0], up = acc[ai][bj][m][1];
#pragma unroll
                    for (int j = 0; j < 4; ++j) o[bj * 4 + j] = gt[j] * __builtin_amdgcn_rcpf(1.f + __expf(-gt[j])) * up[j];
                }
                u32x4 w; w.x = pack2(o[0], o[1]); w.y = pack2(o[2], o[3]); w.z = pack2(o[4], o[5]); w.w = pack2(o[6], o[7]);
                *(u32x4*)(act + (size_t)row * DFF + unit0) = w;
            }
    }
};
struct EpiResid {
    static constexpr bool SPLITK = false;
    bf16_t* Y; const float* gate; float coef;
    DI void operator()(const f32x4 (&acc)[2][2][4][2], int pm, int pn, int wr, int wc, int fr, int fq, bool) const {
        const int row0 = pm * 256 + wr * 64 + fr;
        const int bi = row0 < MLAT ? (row0 >> 12) : 8;
        const int col0 = pn * 256 + wc * 32 + fq * 8;
        f32x4 gv[2][2];
#pragma unroll
        for (int bj = 0; bj < 2; ++bj)
#pragma unroll
            for (int n = 0; n < 2; ++n) gv[bj][n] = coef * *(const f32x4*)(gate + (size_t)bi * 9216 + col0 + bj * 128 + n * 4);
#pragma unroll
        for (int ai = 0; ai < 2; ++ai)
#pragma unroll
            for (int m = 0; m < 4; ++m) {
                bf16_t* yp = Y + (size_t)(row0 + ai * 128 + m * 16) * D + col0;
#pragma unroll
                for (int bj = 0; bj < 2; ++bj) {
                    const f32x4 a = gv[bj][0] * acc[ai][bj][m][0], b = gv[bj][1] * acc[ai][bj][m][1];
                    u32x4 w; w.x = pack2(a[0], a[1]); w.y = pack2(a[2], a[3]); w.z = pack2(b[0], b[1]); w.w = pack2(b[2], b[3]);
                    *(u32x4*)(yp + bj * 128) = w;
                }
            }
    }
};
struct EpiWin {
    static constexpr bool SPLITK = false;
    bf16_t* pa; bf16_t* pbb; bf16_t* pc;
    DI void operator()(const f32x4 (&acc)[2][2][4][2], int pm, int pn, int wr, int wc, int fr, int fq, bool) const {
#pragma unroll
        for (int ai = 0; ai < 2; ++ai)
#pragma unroll
            for (int m = 0; m < 4; ++m) {
                const int row = pm * 256 + ai * 128 + wr * 64 + m * 16 + fr;
#pragma unroll
                for (int bj = 0; bj < 2; ++bj) {
                    const int col = pn * 256 + bj * 128 + wc * 32 + fq * 8;
                    const f32x4 a = acc[ai][bj][m][0], b = acc[ai][bj][m][1];
                    u32x4 w; w.x = pack2(a[0], a[1]); w.y = pack2(a[2], a[3]); w.z = pack2(b[0], b[1]); w.w = pack2(b[2], b[3]);
                    if (col < 640) *(u32x4*)(pa + (size_t)row * 640 + col) = w;
                    else if (col < 1408) *(u32x4*)(pbb + (size_t)row * 768 + (col - 640)) = w;
                    else if (col < 1824) *(u32x4*)(pc + (size_t)row * 416 + (col - 1408)) = w;
                }
            }
    }
};
struct EpiUp {
    static constexpr bool SPLITK = false;
    bf16_t* upb; float qscale;
    DI void operator()(const f32x4 (&acc)[2][2][4][2], int pm, int pn, int wr, int wc, int fr, int fq, bool) const {
#pragma unroll
        for (int ai = 0; ai < 2; ++ai)
#pragma unroll
            for (int m = 0; m < 4; ++m) {
                const int row = pm * 256 + ai * 128 + wr * 64 + m * 16 + fr;
#pragma unroll
                for (int bj = 0; bj < 2; ++bj) {
                    const int col = pn * 256 + bj * 128 + wc * 32 + fq * 8;
                    if (col < 1344) {
                        const float sc = col < 576 ? qscale : 1.f;
                        const f32x4 a = acc[ai][bj][m][0] * sc, b = acc[ai][bj][m][1] * sc;
                        u32x4 w; w.x = pack2(a[0], a[1]); w.y = pack2(a[2], a[3]); w.z = pack2(b[0], b[1]); w.w = pack2(b[2], b[3]);
                        *(u32x4*)(upb + (size_t)row * 1344 + col) = w;
                    }
                }
            }
    }
};

#define G_SA(b, h) (((b) * 2 + (h)) * HTB)
#define G_SB(b, h) ((4 + (b) * 2 + (h)) * HTB)
#define G_STAGE(bufoff, gbase, voff) do { _Pragma("unroll") for (int _i = 0; _i < 2; ++_i) \
        __builtin_amdgcn_global_load_lds((const unsigned*)((const char*)(gbase) + (voff)[_i]), (LAS unsigned*)(lds + (bufoff) + ldsw + _i * 8192), 16, 0, 0); } while (0)
#define G_LDA(dst, b, h) do { _Pragma("unroll") for (int m = 0; m < 4; ++m) _Pragma("unroll") for (int k = 0; k < 2; ++k) dst[m][k] = *(const LAS bf16x8*)(lds + G_SA(b, h) + aoff + m * 2048 + k * 1024); } while (0)
#define G_LDB(dst, b, h) do { _Pragma("unroll") for (int n = 0; n < 2; ++n) _Pragma("unroll") for (int k = 0; k < 2; ++k) dst[n][k] = *(const LAS bf16x8*)(lds + G_SB(b, h) + boff + n * 2048 + k * 1024); } while (0)
#define G_MMA(ai, bj, At, Bt) do { __builtin_amdgcn_s_setprio(1); _Pragma("unroll") for (int m = 0; m < 4; ++m) _Pragma("unroll") for (int n = 0; n < 2; ++n) _Pragma("unroll") for (int k = 0; k < 2; ++k) \
        acc[ai][bj][m][n] = __builtin_amdgcn_mfma_f32_16x16x32_bf16(Bt[n][k], At[m][k], acc[ai][bj][m][n], 0, 0, 0); __builtin_amdgcn_s_setprio(0); } while (0)
#define G_WAIT_V(n) asm volatile("s_waitcnt vmcnt(" #n ")" ::: "memory")
#define G_WAIT_L(n) asm volatile("s_waitcnt lgkmcnt(" #n ")" ::: "memory")
#define G_BAR __builtin_amdgcn_s_barrier()
#define G_SCHED __builtin_amdgcn_sched_barrier(0)

template <class Epi>
DI void gemm_phase(LAS unsigned char* lds, const bf16_t* A, int lda, const bf16_t* Bt, int ldb, int M, int N, int K, const Epi& epi, int pm0 = 0, int vb0 = 0, int vG = 0) {
    const int tid = otid(), wid = __builtin_amdgcn_readfirstlane(tid >> 6), lane = tid & 63, wr = wid >> 2, wc = wid & 3, fr = lane & 15, fq = lane >> 4;
    const int nt = K / BK, nM = M / BM, nN = N / BM, nwg = nM * nN;
    const int G = vG > 0 ? vG : (int)gridDim.x;
    const int vb = obid() - vb0;
    if (vb < 0 || vb >= G || vb >= nwg) return;
    unsigned voffA[2], voffB[2];
#pragma unroll
    for (int i = 0; i < 2; ++i) { int R, C; stage_rc(tid * 16 + i * 8192, R, C); voffA[i] = (unsigned)(R * lda + C) * 2u; voffB[i] = (unsigned)(R * ldb + C) * 2u; }
    const unsigned ldsw = (unsigned)wid * 1024u;
    const int aoff = lds_byte(wr * 64 + fr, fq * 8), boff = lds_byte(wc * 32 + fr, fq * 8);
    const size_t kstep = (size_t)(BK * 2), hA = (size_t)HALF * lda * 2, hB = (size_t)HALF * ldb * 2;
#define G_COORDS(Lx, pmx, pnx) do { int wgid = (Lx); \
        { const int q = nwg / NXCD, r = nwg % NXCD, xcd = wgid % NXCD, off = wgid / NXCD; wgid = (xcd < r ? xcd * (q + 1) : r * (q + 1) + (xcd - r) * q) + off; } \
        const int nig = WGM * nN, gid = wgid / nig, fm = gid * WGM, gsz = (nM - fm) < WGM ? (nM - fm) : WGM; \
        pmx = pm0 + fm + ((wgid % nig) % gsz); pnx = (wgid % nig) / gsz; } while (0)
    int pm, pn; G_COORDS(vb, pm, pn);
    const char* cA = (const char*)(A + (size_t)pm * BM * lda);
    const char* cB = (const char*)(Bt + (size_t)pn * BM * ldb);
    f32x4 acc[2][2][4][2];
#pragma unroll
    for (int a = 0; a < 2; ++a)
#pragma unroll
        for (int b = 0; b < 2; ++b)
#pragma unroll
            for (int m = 0; m < 4; ++m)
#pragma unroll
                for (int n = 0; n < 2; ++n) acc[a][b][m][n] = (f32x4){0.f, 0.f, 0.f, 0.f};
    bf16x8 At[4][2], B0[2][2], B1[2][2];
    G_STAGE(G_SB(0, 0), cB, voffB); G_STAGE(G_SB(0, 1), cB + hB, voffB); G_STAGE(G_SA(0, 0), cA, voffA); G_STAGE(G_SA(0, 1), cA + hA, voffA);
    if (wr == 1) G_BAR;
    G_WAIT_V(2); G_BAR;
    G_STAGE(G_SB(1, 0), cB + kstep, voffB); G_STAGE(G_SA(1, 0), cA + kstep, voffA); G_STAGE(G_SB(1, 1), cB + hB + kstep, voffB);
    G_WAIT_V(6); G_BAR;
    for (int wu = vb;;) {
        const int wn = wu + G;
        const bool has_next = wn < nwg;
        int pmn = pm, pnn = pn;
        if (has_next) G_COORDS(wn, pmn, pnn);
        const char* nA = has_next ? (const char*)(A + (size_t)pmn * BM * lda) : cA;
        const char* nB = has_next ? (const char*)(Bt + (size_t)pnn * BM * ldb) : cB;
        for (int t = 0; t < nt; t += 2) {
            const bool last = (t == nt - 2);
            const char* a1 = cA + (size_t)(t + 1) * kstep;
            const char* a2 = last ? nA : cA + (size_t)(t + 2) * kstep; const char* b2 = last ? nB : cB + (size_t)(t + 2) * kstep;
            const char* a3 = a2 + kstep; const char* b3 = b2 + kstep;
            G_LDB(B0, 0, 0); G_LDB(B1, 0, 1); G_SCHED; G_LDA(At, 0, 0); G_STAGE(G_SA(1, 1), a1 + hA, voffA);
            G_WAIT_V(8); G_WAIT_L(0); G_BAR; G_MMA(0, 0, At, B0); G_MMA(0, 1, At, B1); G_BAR; G_SCHED;
            G_LDA(At, 0, 1); G_STAGE(G_SB(0, 0), b2, voffB); G_STAGE(G_SB(0, 1), b2 + hB, voffB); G_STAGE(G_SA(0, 0), a2, voffA);
            G_WAIT_V(8); G_WAIT_L(0); G_BAR; G_MMA(1, 0, At, B0); G_MMA(1, 1, At, B1); G_BAR; G_SCHED;
            G_LDB(B0, 1, 0); G_LDB(B1, 1, 1); G_SCHED; G_LDA(At, 1, 0); G_STAGE(G_SA(0, 1), a2 + hA, voffA);
            G_WAIT_V(8); G_WAIT_L(0); G_BAR; G_MMA(0, 0, At, B0); G_MMA(0, 1, At, B1); G_BAR; G_SCHED;
            G_LDA(At, 1, 1); G_STAGE(G_SB(1, 0), b3, voffB); G_STAGE(G_SB(1, 1), b3 + hB, voffB); G_STAGE(G_SA(1, 0), a3, voffA);
            G_WAIT_V(8); G_WAIT_L(0); G_BAR; G_MMA(1, 0, At, B0); G_MMA(1, 1, At, B1); G_BAR; G_SCHED;
        }
        if (wr == 0) G_BAR;
        epi(acc, pm, pn, wr, wc, fr, fq, false);
        if (!has_next) break;
#pragma unroll
        for (int a = 0; a < 2; ++a)
#pragma unroll
            for (int b = 0; b < 2; ++b)
#pragma unroll
                for (int m = 0; m < 4; ++m)
#pragma unroll
                    for (int n = 0; n < 2; ++n) acc[a][b][m][n] = (f32x4){0.f, 0.f, 0.f, 0.f};
        pm = pmn; pn = pnn; cA = nA; cB = nB; wu = wn;
        if (wr == 1) G_BAR;
    }
    G_WAIT_V(0);
    G_BAR;
#undef G_COORDS
    __syncthreads();
}
}


DI void phase_post(const Params& p, int l, LAS unsigned char* lds) {
    const int tid_ = otid(); const int lane = tid_ & 63, wv = tid_ >> 6;
    bf16_t* PA = (bf16_t*)(WSP() + OFF_PA);
    const bf16_t* PBB = (const bf16_t*)(WSP() + OFF_PBB);
    const bf16_t* PC = (const bf16_t*)(WSP() + OFF_PC);
    bf16_t* HYU = (bf16_t*)(WSP() + OFF_HYU);
    bf16_t* HYX = (bf16_t*)(WSP() + OFF_HYX);
    bf16_t* KR = (bf16_t*)(WSP() + OFF_KR);
    bf16_t* CN = (bf16_t*)(WSP() + OFF_R1);
    const f32x2* ROPE = (const f32x2*)(WSP() + OFF_ROPE);
    const int hd = lane >> 3, e0 = (lane & 7) * 8;
    float g8[8];
#pragma unroll
    for (int j = 0; j < 8; ++j) g8[j] = (hd < 6 ? INP(14)[l * 64 + e0 + j] : INP(15)[l * 64 + e0 + j]) * (hd < 6 ? 0.125f * LOG2E : 1.f);
    const float* cw = INP(16) + (size_t)l * 3 * 768;
    const float* cb = INP(17) + (size_t)l * 768;
    f32x4 w0[3], w1[3], w2[3], wb[3];
#pragma unroll
    for (int g3 = 0; g3 < 3; ++g3) {
        const int col = g3 * 256 + 4 * lane;
        w0[g3] = *(const f32x4*)(cw + col); w1[g3] = *(const f32x4*)(cw + 768 + col); w2[g3] = *(const f32x4*)(cw + 1536 + col); wb[g3] = *(const f32x4*)(cb + col);
    }
    LAS bf16_t* UT = (LAS bf16_t*)lds;
    LAS bf16_t* XT = UT + 256 * 40;
    for (int tile = obid(); tile < MTOT / 32; tile += gridDim.x) {
      for (int tq = 0; tq < 4; ++tq) {
        const int tt = wv * 4 + tq, tok = tile * 32 + tt;
        const bool lat = tok < MLAT;
        const int t = lat ? (tok & 4095) : ((tok - MLAT) & 255);
        const int n = lat ? SEQ : CTXL;
        bf16_t* pa = PA + (size_t)tok * 640 + lane * 8;
        const u32x4 raw = *(const u32x4*)pa;
        const bf16_t* r0 = PBB + (size_t)tok * 768 + 4 * lane;
        u32x2 c0v[3], cmv[3], cpv[3];
#pragma unroll
        for (int g3 = 0; g3 < 3; ++g3) {
            c0v[g3] = *(const u32x2*)(r0 + g3 * 256);
            cmv[g3] = (u32x2){0u, 0u}; cpv[g3] = (u32x2){0u, 0u};
            if (t > 0) cmv[g3] = *(const u32x2*)(r0 + g3 * 256 - 768);
            if (t < n - 1) cpv[g3] = *(const u32x2*)(r0 + g3 * 256 + 768);
        }
        const bf16_t* pc = PC + (size_t)tok * 416;
        const u32x2 cq = *(const u32x2*)(pc + 4 * lane);
        const unsigned ck = *(const unsigned*)(pc + 256 + 2 * lane);
        const bf16_t krraw = pc[384 + (lane & 31)];
        f32x2 csa[8]; f32x2 csk = {1.f, 0.f};
        if (lat) {
            const f32x2* cs = ROPE + (size_t)t * 48 + (lane & 3) * 8;
#pragma unroll
            for (int j = 0; j < 8; ++j) csa[j] = cs[j];
            csk = ROPE[(size_t)t * 48 + 32 + (lane & 15)];
        }
        {
            float x[8];
#pragma unroll
            for (int j = 0; j < 4; ++j) { x[2 * j] = __uint_as_float(raw[j] << 16); x[2 * j + 1] = __uint_as_float(raw[j] & 0xffff0000u); }
            float ss = 0.f;
#pragma unroll
            for (int j = 0; j < 8; ++j) ss += x[j] * x[j];
            ss += __shfl_xor(ss, 1); ss += __shfl_xor(ss, 2); ss += __shfl_xor(ss, 4);
            const float r = rsqrtf(ss * (1.f / 64.f) + EPS);
#pragma unroll
            for (int j = 0; j < 8; ++j) x[j] *= r * g8[j];
            if (lat) {
#pragma unroll
                for (int j = 0; j < 8; ++j) {
                    const float pr = __shfl_xor(x[j], 4);
                    const f32x2 c = csa[j];
                    x[j] = (lane & 4) ? x[j] * c[0] + pr * c[1] : x[j] * c[0] - pr * c[1];
                }
            }
            u32x4 o; o.x = pack2(x[0], x[1]); o.y = pack2(x[2], x[3]); o.z = pack2(x[4], x[5]); o.w = pack2(x[6], x[7]);
            *(u32x4*)pa = o;
        }
        {
            f32x4 o[3];
#pragma unroll
            for (int g3 = 0; g3 < 3; ++g3) {
                const u32x2 c0 = c0v[g3], cm = cmv[g3], cp = cpv[g3];
                const f32x4 vm = {__uint_as_float(cm.x << 16), __uint_as_float(cm.x & 0xffff0000u), __uint_as_float(cm.y << 16), __uint_as_float(cm.y & 0xffff0000u)};
                const f32x4 v0 = {__uint_as_float(c0.x << 16), __uint_as_float(c0.x & 0xffff0000u), __uint_as_float(c0.y << 16), __uint_as_float(c0.y & 0xffff0000u)};
                const f32x4 vp = {__uint_as_float(cp.x << 16), __uint_as_float(cp.x & 0xffff0000u), __uint_as_float(cp.y << 16), __uint_as_float(cp.y & 0xffff0000u)};
                o[g3] = w0[g3] * vm + w1[g3] * v0 + w2[g3] * vp + wb[g3];
            }
            const f32x4 u = o[0] * o[1];
            u32x2 a; a.x = pack2(u[0], u[1]); a.y = pack2(u[2], u[3]);
            u32x2 b; b.x = pack2(o[2][0], o[2][1]); b.y = pack2(o[2][2], o[2][3]);
#pragma unroll
            for (int j = 0; j < 4; ++j) {
                const unsigned ua = (j & 1) ? ((j < 2 ? a.x : a.y) >> 16) : ((j < 2 ? a.x : a.y) & 0xffffu);
                const unsigned ub = (j & 1) ? ((j < 2 ? b.x : b.y) >> 16) : ((j < 2 ? b.x : b.y) & 0xffffu);
                UT[(4 * lane + j) * 40 + tt] = (bf16_t)ua; XT[(4 * lane + j) * 40 + tt] = (bf16_t)ub;
            }
        }
        {
            const f32x4 v = {__uint_as_float(cq.x << 16), __uint_as_float(cq.x & 0xffff0000u), __uint_as_float(cq.y << 16), __uint_as_float(cq.y & 0xffff0000u)};
            const float rq = rsqrtf(wave_sum((v[0] * v[0] + v[1] * v[1]) + (v[2] * v[2] + v[3] * v[3])) * (1.f / 256.f) + EPS);
            u32x2 oq; oq.x = pack2(v[0] * rq, v[1] * rq); oq.y = pack2(v[2] * rq, v[3] * rq);
            *(u32x2*)(CN + (size_t)tok * 384 + 4 * lane) = oq;
            const float u0 = __uint_as_float(ck << 16), u1 = __uint_as_float(ck & 0xffff0000u);
            const float rk = rsqrtf(wave_sum(u0 * u0 + u1 * u1) * (1.f / 128.f) + EPS);
            *(unsigned*)(CN + (size_t)tok * 384 + 256 + 2 * lane) = pack2(u0 * rk, u1 * rk);
            float kr = bf2f(krraw);
            const float pr = __shfl_xor(kr, 16);
            if (lat) kr = (lane & 16) ? kr * csk[0] + pr * csk[1] : kr * csk[0] - pr * csk[1];
            if (lane < 32) KR[(size_t)tok * 32 + lane] = f2bf(kr);
        }
      }
      __syncthreads();
      {
          const int ch = tid_ >> 1, half = tid_ & 1;
          const u32x4 u0 = *(const LAS u32x4*)(UT + ch * 40 + 16 * half), u1 = *(const LAS u32x4*)(UT + ch * 40 + 16 * half + 8);
          const u32x4 x0 = *(const LAS u32x4*)(XT + ch * 40 + 16 * half), x1 = *(const LAS u32x4*)(XT + ch * 40 + 16 * half + 8);
          bf16_t* du = HYU + (size_t)ch * MTOT + tile * 32 + 16 * half; bf16_t* dx = HYX + (size_t)ch * MTOT + tile * 32 + 16 * half;
          *(u32x4*)du = u0; *(u32x4*)(du + 8) = u1; *(u32x4*)dx = x0; *(u32x4*)(dx + 8) = x1;
      }
      __syncthreads();
    }
}

template <int DQK>
DI void attn_item(LAS unsigned char* lds, const bf16_t* qbase, int q_ld, const bf16_t* kc, const bf16_t* kl, const bf16_t* vc, const bf16_t* vl, int kv_ld,
                  const bf16_t* krc, const bf16_t* krl, int ntiles, bf16_t* obase, const f32x2* rope) {
    constexpr int KS = DQK + 8, VS = 68, KBYTES = 64 * KS * 2, BUF = KBYTES + 64 * VS * 2, NKK = DQK / 16;
    const int tid = otid(), lane = tid & 63, w = tid >> 6, li = lane & 31, h = lane >> 5;
    bf16x8 qf[NKK];
    {
        const bf16_t* qrow = qbase + (size_t)(32 * w + li) * q_ld;
#pragma unroll
        for (int kk = 0; kk < NKK; ++kk) qf[kk] = *(const bf16x8*)(qrow + 16 * kk + 8 * h);
        if (DQK == 96 && rope != nullptr) {
            const f32x2* cs = rope + (size_t)(32 * w + li) * 48 + 8 * h;
            bf16x8 a = qf[NKK - 2], b = qf[NKK - 1];
#pragma unroll
            for (int j = 0; j < 8; ++j) {
                const float x1 = bf2f((bf16_t)a[j]), x2 = bf2f((bf16_t)b[j]);
                const f32x2 c = cs[j];
                a[j] = (short)f2bf(x1 * c[0] - x2 * c[1]);
                b[j] = (short)f2bf(x2 * c[0] + x1 * c[1]);
            }
            qf[NKK - 2] = a; qf[NKK - 1] = b;
        }
    }
    f32x16 ot[2];
#pragma unroll
    for (int i = 0; i < 16; ++i) { ot[0][i] = 0.f; ot[1][i] = 0.f; }
    float m_run = -INFINITY, l_run = 0.f;
    const int kkey = tid >> 3, kch = tid & 7;
    const int vkey = lane, vch = w;
    const int rkey = tid >> 2, rch = tid & 3;
    u32x4 kreg, vreg, rreg;
    const unsigned voffK = (unsigned)(kkey * kv_ld + 8 * kch) * 2u, voffV = (unsigned)(vkey * kv_ld + 8 * vch) * 2u, voffR = (unsigned)(rkey * 32 + 8 * rch) * 2u;
#define ATT_LOAD(j) do { const int s0 = (j) * 64; \
        const char* kb_ = (const char*)(s0 < CTXL ? kc + (size_t)s0 * kv_ld : kl + (size_t)(s0 - CTXL) * kv_ld); \
        const char* vb_ = (const char*)(s0 < CTXL ? vc + (size_t)s0 * kv_ld : vl + (size_t)(s0 - CTXL) * kv_ld); \
        kreg = *(const u32x4*)(kb_ + voffK); \
        vreg = *(const u32x4*)(vb_ + voffV); \
        if (DQK == 96 && tid < 256) { const char* rb = (const char*)(s0 < CTXL ? krc + (size_t)s0 * 32 : krl + (size_t)(s0 - CTXL) * 32); rreg = *(const u32x4*)(rb + voffR); } } while (0)
#define ATT_STORE(bufi) do { LAS unsigned char* kb_ = lds + (bufi) * BUF; LAS bf16_t* vt_ = (LAS bf16_t*)(kb_ + KBYTES); \
        *(LAS u32x4*)(kb_ + (kkey * KS + 8 * kch) * 2) = kreg; \
        if (DQK == 96 && tid < 256) *(LAS u32x4*)(kb_ + (rkey * KS + 64 + 8 * rch) * 2) = rreg; \
        _Pragma("unroll") for (int e = 0; e < 4; ++e) { const unsigned wd = vreg[e]; vt_[(8 * vch + 2 * e) * VS + vkey] = (bf16_t)(wd & 0xffffu); vt_[(8 * vch + 2 * e + 1) * VS + vkey] = (bf16_t)(wd >> 16); } } while (0)
    ATT_LOAD(0);
    ATT_STORE(0);
    __syncthreads();
    bf16x8 vf[2][2][2];
    f32x16 st[2];
#define ATT_X(j) do { \
        const LAS unsigned char* kb = lds + ((j) & 1) * BUF; const LAS unsigned char* vt = kb + KBYTES; \
        bf16x8 kf[2][NKK]; \
        _Pragma("unroll") for (int kt = 0; kt < 2; ++kt) _Pragma("unroll") for (int kk = 0; kk < NKK; ++kk) kf[kt][kk] = *(const LAS bf16x8*)(kb + ((32 * kt + li) * KS + 16 * kk + 8 * h) * 2); \
        _Pragma("unroll") for (int vtile = 0; vtile < 2; ++vtile) _Pragma("unroll") for (int kt = 0; kt < 2; ++kt) _Pragma("unroll") for (int s = 0; s < 2; ++s) { \
            const LAS unsigned char* ap = vt + ((32 * vtile + li) * VS + 32 * kt + 16 * s + 4 * h) * 2; \
            const u32x2 lo = *(const LAS u32x2*)ap, hi = *(const LAS u32x2*)(ap + 16); \
            u32x4 vv; vv.x = lo.x; vv.y = lo.y; vv.z = hi.x; vv.w = hi.y; vf[vtile][kt][s] = __builtin_bit_cast(bf16x8, vv); } \
        _Pragma("unroll") for (int kt = 0; kt < 2; ++kt) { \
            _Pragma("unroll") for (int i = 0; i < 16; ++i) st[kt][i] = 0.f; \
            _Pragma("unroll") for (int kk = 0; kk < NKK; ++kk) st[kt] = MFMA32(kf[kt][kk], qf[kk], st[kt]); } } while (0)
#define ATT_Y() do { \
        float mx = fmaxf(fmaxf(st[0][0], st[0][1]), st[0][2]); \
        _Pragma("unroll") for (int i = 3; i < 15; i += 2) mx = fmaxf(fmaxf(mx, st[0][i]), st[0][i + 1]); \
        mx = fmaxf(mx, st[0][15]); \
        _Pragma("unroll") for (int i = 0; i < 16; i += 2) mx = fmaxf(fmaxf(mx, st[1][i]), st[1][i + 1]); \
        mx = fmaxf(mx, __shfl_xor(mx, 32)); \
        if (__any(mx > m_run + 8.f)) { \
            const float m_new = fmaxf(m_run, mx); const float alpha = fast_exp2(m_run - m_new); m_run = m_new; l_run *= alpha; \
            _Pragma("unroll") for (int i = 0; i < 16; ++i) { ot[0][i] *= alpha; ot[1][i] *= alpha; } } \
        { const f32x2 m2 = {m_run, m_run}; f32x2 rs2 = {0.f, 0.f}; \
          _Pragma("unroll") for (int kt = 0; kt < 2; ++kt) _Pragma("unroll") for (int i = 0; i < 16; i += 2) { \
              f32x2 d = (f32x2){st[kt][i], st[kt][i + 1]} - m2; d[0] = fast_exp2(d[0]); d[1] = fast_exp2(d[1]); rs2 += d; st[kt][i] = d[0]; st[kt][i + 1] = d[1]; } \
          l_run += rs2[0] + rs2[1]; } \
        _Pragma("unroll") for (int kt = 0; kt < 2; ++kt) _Pragma("unroll") for (int s = 0; s < 2; ++s) { \
            u32x4 pk; pk.x = pack2(st[kt][8 * s + 0], st[kt][8 * s + 1]); pk.y = pack2(st[kt][8 * s + 2], st[kt][8 * s + 3]); \
            pk.z = pack2(st[kt][8 * s + 4], st[kt][8 * s + 5]); pk.w = pack2(st[kt][8 * s + 6], st[kt][8 * s + 7]); \
            const bf16x8 pf = __builtin_bit_cast(bf16x8, pk); \
            ot[0] = MFMA32(vf[0][kt][s], pf, ot[0]); ot[1] = MFMA32(vf[1][kt][s], pf, ot[1]); } } while (0)
    if (w < 4) {
        for (int j = 0; j < ntiles; ++j) {
            if (j + 1 < ntiles) ATT_LOAD(j + 1);
            ATT_X(j);
            __builtin_amdgcn_s_barrier();
            ATT_Y();
            if (j + 1 < ntiles) ATT_STORE((j + 1) & 1);
            asm volatile("s_waitcnt lgkmcnt(0)" ::: "memory");
            __builtin_amdgcn_s_barrier();
        }
        __builtin_amdgcn_s_barrier();
    } else {
        if (1 < ntiles) ATT_LOAD(1);
        __builtin_amdgcn_s_barrier();
        for (int j = 0; j < ntiles; ++j) {
            ATT_X(j);
            if (j + 1 < ntiles) ATT_STORE((j + 1) & 1);
            asm volatile("s_waitcnt lgkmcnt(0)" ::: "memory");
            __builtin_amdgcn_s_barrier();
            if (j + 2 < ntiles) ATT_LOAD(j + 2);
            ATT_Y();
            __builtin_amdgcn_s_barrier();
        }
    }
#undef ATT_X
#undef ATT_Y
#undef ATT_LOAD
#undef ATT_STORE
    const float lt = l_run + __shfl_xor(l_run, 32);
    const float inv = 1.f / lt;
    bf16_t* orow = obase + (size_t)(32 * w + li) * 1024;
#pragma unroll
    for (int vtile = 0; vtile < 2; ++vtile)
#pragma unroll
        for (int g4 = 0; g4 < 4; ++g4) {
            u32x2 o; o.x = pack2(ot[vtile][4 * g4 + 0] * inv, ot[vtile][4 * g4 + 1] * inv); o.y = pack2(ot[vtile][4 * g4 + 2] * inv, ot[vtile][4 * g4 + 3] * inv);
            *(u32x2*)(orow + 32 * vtile + 8 * g4 + 4 * h) = o;
        }
}

#ifndef HYPROBE
#define HYPROBE 0
#endif
template <int NBLK>
DI void hyena_item(LAS unsigned char* lds, const bf16_t* kf, float inv_norm, float dskip, const bf16_t* hyu, const bf16_t* hyx, bf16_t* mix, int tok0) {
    constexpr int n = 64 * NBLK, CL = 2 * n + 32, NCT = NBLK >= 64 ? 2 : 1;
    const int tid = otid(), lane = tid & 63, w = tid >> 6, li = lane & 31, h = lane >> 5;
    LAS bf16_t* cp = (LAS bf16_t*)lds;
    LAS bf16_t* U = cp + 4 * CL;
    for (int ch = tid; ch < (2 * n) / 8; ch += NTHR) {
        const u32x4 raw = *(const u32x4*)(kf + 8 * ch);
#pragma unroll
        for (int e = 0; e < 8; ++e) {
            const bf16_t v = (e & 1) ? (bf16_t)(raw[e >> 1] >> 16) : (bf16_t)(raw[e >> 1] & 0xffffu);
            const int x = 8 * ch + e;
#pragma unroll
            for (int r = 0; r < 4; ++r) cp[r * CL + 2 * n + 3 - r - x] = v;
        }
    }
    if (tid < 144) {
        const int r = tid / 36, k = tid % 36, idx = k < 4 ? k : 2 * n + (k - 4);
        if (idx < 4 - r || idx > 2 * n + 3 - r) cp[r * CL + idx] = (bf16_t)0;
    }
    {
        const bf16_t* hb = hyu + tok0;
        for (int i8 = tid; i8 < n; i8 += NTHR) {
            const int idx = 8 * i8, b = idx / n, s = idx % n;
            *(LAS u32x4*)(U + (b * NBLK + (s >> 6)) * 72 + (s & 63)) = *(const u32x4*)(hb + idx);
        }
    }
    __syncthreads();
    unsigned long long hyt0_ = 0; if (HYPROBE == 1) hyt0_ = __builtin_amdgcn_s_memrealtime();
    f32x16 acc[2][NCT];
#pragma unroll
    for (int mt = 0; mt < 2; ++mt)
#pragma unroll
        for (int ct = 0; ct < NCT; ++ct)
#pragma unroll
            for (int i = 0; i < 16; ++i) acc[mt][ct][i] = 0.f;
    const LAS bf16_t* Uw = U + (size_t)w * NBLK * 72;
#pragma unroll 1
    for (int d = -(NBLK - 1); d <= NBLK - 1; ++d) {
        bool act[NCT]; int blk[NCT]; bool val[NCT];
#pragma unroll
        for (int ct = 0; ct < NCT; ++ct) {
            act[ct] = (32 * ct + 31 - d >= 0) && (32 * ct - d <= NBLK - 1);
            const int a = 32 * ct + li; blk[ct] = a - d; val[ct] = (blk[ct] >= 0) && (blk[ct] < NBLK) && (a < NBLK);
        }
#pragma unroll
        for (int ks = 0; ks < 4; ++ks) {
            bf16x8 af[2];
#pragma unroll
            for (int mt = 0; mt < 2; ++mt) {
                const int y0 = n - 1 - 64 * d - (32 * mt + li) + 16 * ks + 8 * h;
                const int r = y0 & 3, m0 = y0 - r + 4;
                const LAS bf16_t* ap = cp + r * CL + m0;
                const u32x2 lo = *(const LAS u32x2*)ap, hi = *(const LAS u32x2*)(ap + 4);
                u32x4 vv; vv.x = lo.x; vv.y = lo.y; vv.z = hi.x; vv.w = hi.y;
                af[mt] = __builtin_bit_cast(bf16x8, vv);
            }
#pragma unroll
            for (int ct = 0; ct < NCT; ++ct) {
                if (act[ct]) {
                    u32x4 bv = {0u, 0u, 0u, 0u};
                    if (val[ct]) bv = *(const LAS u32x4*)(Uw + blk[ct] * 72 + 16 * ks + 8 * h);
                    const bf16x8 bfv = __builtin_bit_cast(bf16x8, bv);
                    acc[0][ct] = MFMA32(af[0], bfv, acc[0][ct]);
                    acc[1][ct] = MFMA32(af[1], bfv, acc[1][ct]);
                }
            }
        }
    }
    if (HYPROBE == 1 && NBLK == 64) { __syncthreads(); if (threadIdx.x == 0) *(LAS unsigned long long*)(lds + LDS_BYTES - 32) += __builtin_amdgcn_s_memrealtime() - hyt0_; }
#pragma unroll
    for (int mt = 0; mt < 2; ++mt)
#pragma unroll
        for (int ct = 0; ct < NCT; ++ct) {
            const int a = 32 * ct + li;
            if (a < NBLK) {
                unsigned tokb = (unsigned)(tok0 + w * n + 64 * a + 32 * mt + 4 * h);
                asm volatile("" : "+v"(tokb));
                const LAS bf16_t* up = Uw + a * 72 + 32 * mt + 4 * h;
                u32x2 xvv[4];
#pragma unroll
                for (int g = 0; g < 4; ++g) xvv[g] = *(const u32x2*)(hyx + tokb + 8u * g);
#pragma unroll
                for (int g = 0; g < 4; ++g) {
                    const unsigned tok = tokb + 8u * g;
                    const u32x2 xv = xvv[g];
                    const u32x2 uv = *(const LAS u32x2*)(up + 8 * g);
                    float o[4];
#pragma unroll
                    for (int j = 0; j < 4; ++j) {
                        const unsigned xw = j < 2 ? xv.x : xv.y, uw = j < 2 ? uv.x : uv.y;
                        const float x0 = (j & 1) ? __uint_as_float(xw & 0xffff0000u) : __uint_as_float(xw << 16);
                        const float uu = (j & 1) ? __uint_as_float(uw & 0xffff0000u) : __uint_as_float(uw << 16);
                        o[j] = (acc[mt][ct][4 * g + j] * inv_norm + uu * dskip) * x0;
                    }
                    u32x2 ov; ov.x = pack2(o[0], o[1]); ov.y = pack2(o[2], o[3]);
                    *(u32x2*)(mix + tok) = ov;
                }
            }
            __builtin_amdgcn_sched_barrier(0);
        }
}

DI void phase_mix(const Params& p, int l, bool need_ctx, LAS unsigned char* lds) {
    const bf16_t* PA = (const bf16_t*)(WSP() + OFF_PA);
    const bf16_t* UPB = (const bf16_t*)(WSP() + OFF_UPB);
    const bf16_t* KR = (const bf16_t*)(WSP() + OFF_KR);
    const bf16_t* HYU = (const bf16_t*)(WSP() + OFF_HYU);
    const bf16_t* HYX = (const bf16_t*)(WSP() + OFF_HYX);
    bf16_t* MIX = (bf16_t*)(WSP() + OFF_R1);
    const f32x2* ROPE = (const f32x2*)(WSP() + OFF_ROPE);
    const int n_items = 256 + 768 + 768 + (need_ctx ? 48 + 48 + 256 : 0);
    LAS float* red = (LAS float*)lds;
    for (int it = obid(); it < n_items; it += gridDim.x) {
        int lin = 0;
        if (it >= 256 && it < 1792) { const int j = it - 256, r = j >> 8, bp = j & 255; lin = ((r * 8 + (bp & 7)) << 5) + (bp >> 3); }
#ifndef MIXSEL
#define MIXSEL 0
#endif
        if ((MIXSEL == 0 || MIXSEL == 1) && (it < 256 || it >= 1888)) {
            const bool isl = it < 256;
            const int c = isl ? it : it - 1888;
            const float* part = isl ? (const float*)(WSP() + OFF_PART) + (size_t)l * 128 * 512 : (const float*)(WSP() + OFF_PARTC) + (size_t)l * 8 * 512;
            const int np = isl ? 128 : 8;
            float s = 0.f;
            const int tq_ = otid();
            if (tq_ < 2 * np) { const int r = tq_ >> 1, hb = tq_ & 1; s = part[(size_t)r * 512 + hb * 256 + c]; }
            s = wave_sum(s);
            __syncthreads();
            if ((tq_ & 63) == 0) red[tq_ >> 6] = s;
            __syncthreads();
            float nrm = 0.f;
#pragma unroll
            for (int i = 0; i < 8; ++i) nrm += red[i];
            __syncthreads();
            const float inv_norm = 1.f / nrm, dskip = INP(26)[l * 256 + c];
            bf16_t* OBT = (bf16_t*)(WSP() + OFF_OBT);
            if (isl) hyena_item<64>(lds, (const bf16_t*)(WSP() + OFF_KF) + ((size_t)l * 256 + c) * 8192, inv_norm, dskip, HYU + (size_t)c * MTOT, HYX + (size_t)c * MTOT, OBT + (size_t)c * MTOT, 0);
            else hyena_item<4>(lds, (const bf16_t*)(WSP() + OFF_KFC) + ((size_t)l * 256 + c) * 512, inv_norm, dskip, HYU + (size_t)c * MTOT, HYX + (size_t)c * MTOT, OBT + (size_t)c * MTOT, MLAT);
        } else if ((MIXSEL == 0 || MIXSEL == 2) && it < 1792 && lin < 768) {
            const int idx = lin, qb = idx & 15, hd = (idx >> 4) % 6, b = idx / 96, hk = hd / 3;
            const size_t tl = (size_t)b * SEQ, tc = (size_t)MLAT + (size_t)b * CTXL;
            attn_item<64>(lds, PA + (tl + qb * 256) * 640 + hd * 64, 640, PA + tc * 640 + 384 + hk * 64, PA + tl * 640 + 384 + hk * 64,
                          PA + tc * 640 + 512 + hk * 64, PA + tl * 640 + 512 + hk * 64, 640, nullptr, nullptr, 68, MIX + (tl + qb * 256) * 1024 + hd * 64, nullptr);
        } else if ((MIXSEL == 0 || MIXSEL == 3) && it < 1792) {
            const int idx = lin - 768, qb = idx & 15, hd = (idx >> 4) % 6, b = idx / 96;
            const size_t tl = (size_t)b * SEQ, tc = (size_t)MLAT + (size_t)b * CTXL;
            attn_item<96>(lds, UPB + (tl + qb * 256) * 1344 + hd * 96, 1344, UPB + tc * 1344 + 576 + hd * 128, UPB + tl * 1344 + 576 + hd * 128,
                          UPB + tc * 1344 + 576 + hd * 128 + 64, UPB + tl * 1344 + 576 + hd * 128 + 64, 1344, KR + tc * 32, KR + tl * 32, 68,
                          MIX + (tl + qb * 256) * 1024 + 640 + hd * 64, ROPE + (size_t)(qb * 256) * 48 + 32);
        } else if ((MIXSEL == 0 || MIXSEL == 2) && it < 1840) {
            const int idx = it - 1792, hd = idx % 6, b = idx / 6, hk = hd / 3;
            const size_t tc = (size_t)MLAT + (size_t)b * CTXL;
            attn_item<64>(lds, PA + tc * 640 + hd * 64, 640, PA + tc * 640 + 384 + hk * 64, PA + tc * 640 + 384 + hk * 64,
                          PA + tc * 640 + 512 + hk * 64, PA + tc * 640 + 512 + hk * 64, 640, nullptr, nullptr, 4, MIX + tc * 1024 + hd * 64, nullptr);
        } else if (MIXSEL == 0 || MIXSEL == 3) {
            const int idx = it - 1840, hd = idx % 6, b = idx / 6;
            const size_t tc = (size_t)MLAT + (size_t)b * CTXL;
            attn_item<96>(lds, UPB + tc * 1344 + hd * 96, 1344, UPB + tc * 1344 + 576 + hd * 128, UPB + tc * 1344 + 576 + hd * 128,
                          UPB + tc * 1344 + 576 + hd * 128 + 64, UPB + tc * 1344 + 576 + hd * 128 + 64, 1344, KR + tc * 32, KR + tc * 32, 4,
                          MIX + tc * 1024 + 640 + hd * 64, nullptr);
        }
        __syncthreads();
    }
}

DI void phase_untranspose(const Params& p, bool need_ctx, LAS unsigned char* lds) {
    const int tid = otid();
    const bf16_t* OBT = (const bf16_t*)(WSP() + OFF_OBT);
    bf16_t* MIX = (bf16_t*)(WSP() + OFF_R1);
    LAS bf16_t* T = (LAS bf16_t*)lds;
    const int ntile = (need_ctx ? MTOT : MLAT) / 64;
    for (int tile = obid(); tile < ntile; tile += gridDim.x) {
        {
            const int ch = tid >> 1, half = tid & 1;
            const bf16_t* src = OBT + (size_t)ch * MTOT + tile * 64 + 32 * half;
#pragma unroll
            for (int q = 0; q < 4; ++q) *(LAS u32x4*)(T + ch * 72 + 32 * half + 8 * q) = *(const u32x4*)(src + 8 * q);
        }
        __syncthreads();
        {
            const int tk = tid >> 3, cg = (tid & 7) * 32;
            unsigned w[16];
#pragma unroll
            for (int j = 0; j < 16; ++j) w[j] = (unsigned)T[(cg + 2 * j) * 72 + tk] | ((unsigned)T[(cg + 2 * j + 1) * 72 + tk] << 16);
            bf16_t* dst = MIX + (size_t)(tile * 64 + tk) * 1024 + 384 + cg;
#pragma unroll
            for (int q = 0; q < 4; ++q) { u32x4 o; o.x = w[4 * q]; o.y = w[4 * q + 1]; o.z = w[4 * q + 2]; o.w = w[4 * q + 3]; *(u32x4*)(dst + 8 * q) = o; }
        }
        __syncthreads();
    }
}

#define XB_TMO      128
#define XB_XCNT(j)  (256  + 64 * (j))
#define XB_XSUB(j)  (1280 + 64 * (j))
#define XB_XGEN(j)  (2304 + 64 * (j))
#define XB_TOP      3328
#define XB_TOPGEN   3392
#define XCD_BAR_WORDS 3456
#define XB_SPIN_CAP (1u << 22)
DI unsigned xb_ld(unsigned* p)              { return __hip_atomic_load(p, __ATOMIC_RELAXED, __HIP_MEMORY_SCOPE_AGENT); }
DI unsigned xb_add(unsigned* p, unsigned v) { return __hip_atomic_fetch_add(p, v, __ATOMIC_RELAXED, __HIP_MEMORY_SCOPE_AGENT); }
DI unsigned xb_xcc_id() { return (unsigned)__builtin_amdgcn_s_getreg((3 << 11) | 20) & 0xFu; }
#define XB_SPIN(cond, bar) do { unsigned _sp = 0; while (cond) { __builtin_amdgcn_s_sleep(1); \
    if ((++_sp & 255u) == 0u) { if (xb_ld(&(bar)[XB_TMO])) break; if (_sp > XB_SPIN_CAP) { atomicAdd(&(bar)[XB_TMO], 1u); break; } } } } while (0)
struct XcdBarrier { unsigned* bar; unsigned x; volatile LAS unsigned* st; };
DI XcdBarrier xcd_barrier_post(unsigned* bar, volatile LAS unsigned* st) {
    XcdBarrier b; b.bar = bar; b.x = xb_xcc_id(); b.st = st;
    if (threadIdx.x == 0) (void)xb_add(&bar[XB_XCNT(b.x)], 1u);
    return b;
}
DI void xcd_barrier_complete(unsigned* bar, unsigned x, unsigned& nloc, unsigned& nx) {
    const unsigned G = gridDim.x * gridDim.y * gridDim.z;
    unsigned sum, cnt, mine, sp = 0u;
    for (;;) {
        sum = 0u; cnt = 0u; mine = 0u;
#pragma unroll
        for (unsigned j = 0; j < 16; ++j) { const unsigned c = xb_ld(&bar[XB_XCNT(j)]); sum += c; cnt += (c > 0u) ? 1u : 0u; mine = (j == x) ? c : mine; }
        if (sum == G) break;
        __builtin_amdgcn_s_sleep(1);
        if ((++sp & 255u) == 0u) { if (xb_ld(&bar[XB_TMO])) break; if (sp > XB_SPIN_CAP) { atomicAdd(&bar[XB_TMO], 1u); break; } }
    }
    nloc = mine > 0u ? mine : 1u; nx = cnt > 0u ? cnt : 1u;
}
DI void xcd_barrier(const XcdBarrier& b) {
    asm volatile("s_waitcnt vmcnt(0)" ::: "memory");
    __syncthreads();
    if (threadIdx.x == 0) {
        unsigned* bar = b.bar;
        __builtin_amdgcn_s_waitcnt(0);
        unsigned nloc = b.st[0], nx = b.st[1];
        if (nloc == 0u) { xcd_barrier_complete(bar, b.x, nloc, nx); b.st[0] = nloc; b.st[1] = nx; }
        const unsigned old = xb_add(&bar[XB_XSUB(b.x)], 1u);
        const unsigned gen = old / nloc;
        if (old + 1u == (gen + 1u) * nloc) {
            __builtin_amdgcn_fence(__ATOMIC_RELEASE, "agent");
            asm volatile("s_waitcnt vmcnt(0)" ::: "memory");
            const unsigned og = xb_add(&bar[XB_TOP], 1u);
            const unsigned tg = og / nx;
            if (og + 1u == (tg + 1u) * nx) xb_add(&bar[XB_TOPGEN], 1u);
            else XB_SPIN(xb_ld(&bar[XB_TOPGEN]) == tg, bar);
            __builtin_amdgcn_fence(__ATOMIC_ACQUIRE, "agent");
            xb_add(&bar[XB_XGEN(b.x)], 1u);
            asm volatile("s_waitcnt vmcnt(0)" ::: "memory");
        } else {
            XB_SPIN(xb_ld(&bar[XB_XGEN(b.x)]) == gen, bar);
            __builtin_amdgcn_fence(__ATOMIC_ACQUIRE, "agent");
            asm volatile("s_waitcnt vmcnt(0)" ::: "memory");
        }
    }
    __syncthreads();
}

__global__ void __launch_bounds__(NTHR) mega(Params p) {
    extern __shared__ __attribute__((aligned(16))) unsigned char lds_raw[];
    LAS unsigned char* lds = (LAS unsigned char*)lds_raw;
    cg::grid_group grid = cg::this_grid();
    int ph = 0;
#ifndef ONLY
#define ONLY -1
#endif
#ifndef TPROBE
#define TPROBE -1
#endif
#define PHASE(kind, body) do { if ((ONLY < 0 || ONLY == (kind)) && ph >= p.ph_lo && ph < p.ph_hi) { \
        unsigned long long t0_ = 0; if (TPROBE == (kind)) t0_ = __builtin_amdgcn_s_memrealtime(); \
        { unsigned char* ws = WSP(); body; } \
        if (ph + 1 < p.ph_hi) { if (ph == 0) grid.sync(); else xcd_barrier(xbar); } \
        if (TPROBE == (kind)) tprobe += __builtin_amdgcn_s_memrealtime() - t0_; } ++ph; } while (0)
    unsigned long long tprobe = 0;
    {
        volatile LAS unsigned* st = (volatile LAS unsigned*)(lds + LDS_BYTES - 16);
        if (threadIdx.x == 0) { st[0] = 0u; st[1] = 0u; *(LAS unsigned long long*)(lds + LDS_BYTES - 32) = 0ull; }
        __syncthreads();
    }
    XcdBarrier xbar = xcd_barrier_post((unsigned*)(WSP() + OFF_BAR), (volatile LAS unsigned*)(lds + LDS_BYTES - 16));
#ifndef DUP_P0
#define DUP_P0 1
#endif
#pragma unroll 1
    for (int rep = 0; rep < DUP_P0; ++rep) {
    PHASE(0, phase_p0a(p, lds));
    PHASE(1, phase_ln(p, MTOT, true, nullptr, nullptr, true, 0, 0, 1, false));
    }
#ifndef XSYNC
#define XSYNC 0
#endif
#pragma unroll 1
    for (int rep = 0; rep < XSYNC; ++rep) grid.sync();
#pragma unroll 1
    for (int l = 0; l < 2; ++l) {
#pragma unroll 1
        for (int s = 0; s < 3; ++s) {
#define X ((float*)(ws + OFF_X))
#define H ((bf16_t*)(ws + OFF_R1))
#define ACT ((bf16_t*)(ws + OFF_R2))
#define W (ws + OFF_W + (size_t)l * SZ_WL)
#define mod ((const float*)(ws + OFF_MOD) + (size_t)l * 9 * 9216)
            const int Mrows = (l == 1 && s == 2) ? MLAT : MTOT;
            if (s != 1) {
#define wgu ((const bf16_t*)(W + (s == 0 ? WO_GU1 : WO_GU2)))
#define wd ((const bf16_t*)(W + (s == 0 ? WO_D1 : WO_D2)))
#ifndef DUP_GU
#define DUP_GU 1
#endif
#ifndef DUP_MIX
#define DUP_MIX 1
#endif
#pragma unroll 1
                for (int rep = 0; rep < DUP_GU; ++rep)
                PHASE(2, gm::gemm_phase(lds, H, 1024, wgu, 1024, Mrows, 5632, 1024, gm::EpiSwiglu{ACT}));
                const bool last = (l == 1 && s == 2);
                const bool dm = !last;
                const int lm = (s == 0) ? l : l + 1;
                const float* lg = INP(10) + (size_t)(l * 3 + s) * D; const float* lb = INP(11) + (size_t)(l * 3 + s) * D;
#define YD ((bf16_t*)(ws + OFF_R1))
#define er (gm::EpiResid{YD, mod + (s == 0 ? 2 : 8) * 1024, 0.5f})
                PHASE(3, gm::gemm_phase(lds, ACT, DFF, wd, DFF, MLAT, 1024, DFF, er));
                if (Mrows == MTOT) {
                    PHASE(9, { if (obid() < 32) gm::gemm_phase(lds, ACT, DFF, wd, DFF, MCTX, 1024, DFF, er, MLAT / 256, 0, 32);
                               else phase_ln(p, MLAT, false, lg, lb, dm, dm ? lm : 0, s == 0 ? 3 : 0, s == 0 ? 4 : 1, last, 0, 32, (int)gridDim.x - 32, YD); });
                    PHASE(1, phase_ln(p, MTOT, false, lg, lb, dm, dm ? lm : 0, s == 0 ? 3 : 0, s == 0 ? 4 : 1, last, MLAT, 0, 0, YD));
                } else {
                    PHASE(1, phase_ln(p, MLAT, false, lg, lb, dm, dm ? lm : 0, s == 0 ? 3 : 0, s == 0 ? 4 : 1, last, 0, 0, 0, YD));
                }
            } else {
#ifndef DUP_WP
#define DUP_WP 1
#endif
#pragma unroll 1
                for (int rep = 0; rep < DUP_WP; ++rep) {
                PHASE(4, gm::gemm_phase(lds, H, 1024, (const bf16_t*)(W + WO_IN), 1024, MTOT, 2048, 1024,
                                     gm::EpiWin{(bf16_t*)(ws + OFF_PA), (bf16_t*)(ws + OFF_PBB), (bf16_t*)(ws + OFF_PC)}));
                PHASE(5, phase_post(p, l, lds));
                }
                PHASE(6, gm::gemm_phase(lds, (const bf16_t*)(ws + OFF_R1), 384, (const bf16_t*)(W + WO_UP), 384, MTOT, 1536, 384,
                                     gm::EpiUp{(bf16_t*)(ws + OFF_UPB), 0.10206207261596577f * LOG2E}));
#pragma unroll 1
                for (int rep = 0; rep < DUP_MIX; ++rep)
{                 PHASE(7, phase_mix(p, l, l == 0, lds)); }
                PHASE(10, phase_untranspose(p, l == 0, lds));
                const float* lg = INP(10) + (size_t)(l * 3 + 1) * D; const float* lb = INP(11) + (size_t)(l * 3 + 1) * D;
#undef er
#undef YD
#define YD ((bf16_t*)(ws + OFF_R2))
#define er (gm::EpiResid{YD, mod + 5 * 1024, 1.0f})
#define MIXp ((const bf16_t*)(ws + OFF_R1))
#define wo ((const bf16_t*)(W + WO_OUT))
                PHASE(8, gm::gemm_phase(lds, MIXp, 1024, wo, 1024, MLAT, 1024, 1024, er));
                if (l == 0) {
                    PHASE(9, { if (obid() < 32) gm::gemm_phase(lds, MIXp, 1024, wo, 1024, MCTX, 1024, 1024, er, MLAT / 256, 0, 32);
                               else phase_ln(p, MLAT, false, lg, lb, true, l, 6, 7, false, 0, 32, (int)gridDim.x - 32, YD); });
                    PHASE(1, phase_ln(p, MTOT, false, lg, lb, true, l, 6, 7, false, MLAT, 0, 0, YD));
                } else {
                    PHASE(1, phase_ln(p, MLAT, false, lg, lb, true, l, 6, 7, false, 0, 0, 0, YD));
                }
            }
        }
    }
    if (HYPROBE || PPROBE) tprobe = *(LAS unsigned long long*)(lds + LDS_BYTES - 32);
    if (TPROBE >= 0 || HYPROBE || PPROBE) {
        xcd_barrier(xbar);
        if (obid() == 0) {
            const unsigned m = (unsigned)(tprobe / 10ull);
            for (unsigned i = threadIdx.x; i < m && i < 200000u; i += NTHR) OUTP()[(size_t)i * 131u] += 0.1f;
        }
    }
}

constexpr int NPHASES = 1 << 20;

extern "C" void kernel_launch(void* const* d_in, const int* in_sizes, int n_in, void* d_out, int out_size, void* d_ws, size_t ws_size, hipStream_t stream) {
    static int grid = 0;
    if (grid == 0) {
        if (n_in != 31 || ws_size < WS_END) { fprintf(stderr, "kernel_launch: unexpected n_in %d or ws_size %zu (< %zu)\n", n_in, ws_size, (size_t)WS_END); grid = -1; return; }
        int dev = 0, cus = 0, per_cu = 0;
        hipGetDevice(&dev);
        hipDeviceGetAttribute(&cus, hipDeviceAttributeMultiprocessorCount, dev);
        if (hipFuncSetAttribute((const void*)mega, hipFuncAttributeMaxDynamicSharedMemorySize, LDS_BYTES) != hipSuccess) { fprintf(stderr, "kernel_launch: hipFuncSetAttribute failed\n"); grid = -1; return; }
        if (hipOccupancyMaxActiveBlocksPerMultiprocessor(&per_cu, (const void*)mega, NTHR, LDS_BYTES) != hipSuccess || per_cu < 1) { fprintf(stderr, "kernel_launch: occupancy query failed (%d)\n", per_cu); per_cu = 1; }
        (void)hipGetLastError();
        grid = cus * (per_cu > 1 ? 1 : per_cu);
    }
    if (grid < 0) return;
    Params prm{};
    for (int i = 0; i < 31; ++i) prm.in[i] = (const float*)d_in[i];
    prm.out = (float*)d_out; prm.ws = (unsigned char*)d_ws;
    prm.ph_lo = 0; prm.ph_hi = NPHASES;
    (void)hipMemsetAsync((unsigned char*)d_ws + OFF_BAR, 0, 4096 * 4, stream);
    void* args[] = {&prm};
    hipError_t e = hipLaunchCooperativeKernel((const void*)mega, dim3(grid), dim3(NTHR), args, LDS_BYTES, stream);
    if (e != hipSuccess) fprintf(stderr, "kernel_launch: cooperative launch failed: %s (grid %d)\n", hipGetErrorString(e), grid);
}
```

```cpp
#include <hip/hip_runtime.h>
#include <hip/hip_cooperative_groups.h>
#include <cstdio>
#include <cstdint>
namespace cg = cooperative_groups;

#define LAS __attribute__((address_space(3)))
#define DI __device__ __forceinline__
typedef unsigned short bf16_t;
typedef short bf16x8 __attribute__((ext_vector_type(8)));
typedef short s16x4 __attribute__((ext_vector_type(4)));
typedef float f32x2 __attribute__((ext_vector_type(2)));
typedef float f32x4 __attribute__((ext_vector_type(4)));
typedef float f32x16 __attribute__((ext_vector_type(16)));
typedef unsigned u32x2 __attribute__((ext_vector_type(2)));
typedef unsigned u32x4 __attribute__((ext_vector_type(4)));
typedef __bf16 bf2_t __attribute__((ext_vector_type(2)));

constexpr int D = 1024, NB = 8, SEQ = 4096, CTXL = 256, DFF = 2816;
constexpr int MLAT = NB * SEQ, MCTX = NB * CTXL, MTOT = MLAT + MCTX;
constexpr float EPS = 1e-6f, ALPHA = 1.41421356237309515f, LOG2E = 1.44269504088896341f;
constexpr int NTHR = 512;
constexpr int LDS_BYTES = 147456;

constexpr size_t SZ_X = (size_t)MTOT * D * 4;
constexpr size_t WO_GU1 = 0, WO_D1 = WO_GU1 + (size_t)5632 * 1024 * 2, WO_GU2 = WO_D1 + (size_t)1024 * 2816 * 2, WO_D2 = WO_GU2 + (size_t)5632 * 1024 * 2,
                 WO_IN = WO_D2 + (size_t)1024 * 2816 * 2, WO_OUT = WO_IN + (size_t)2048 * 1024 * 2, WO_UP = WO_OUT + (size_t)1024 * 1024 * 2, SZ_WL = WO_UP + (size_t)1536 * 384 * 2;
constexpr size_t OFF_X = 0;
constexpr size_t OFF_W = OFF_X + SZ_X;
constexpr size_t OFF_MOD = OFF_W + 2 * SZ_WL;
constexpr size_t OFF_KF = OFF_MOD + (size_t)2 * 9 * 9216 * 4;
constexpr size_t OFF_KFC = OFF_KF + (size_t)2 * 256 * 8192 * 2;
constexpr size_t OFF_PART = OFF_KFC + (size_t)2 * 256 * 512 * 2;
constexpr size_t OFF_PARTC = OFF_PART + (size_t)2 * 128 * 512 * 4;
constexpr size_t OFF_ROPE = OFF_PARTC + (size_t)2 * 8 * 512 * 4;
constexpr size_t OFF_R1 = OFF_ROPE + (size_t)4096 * 48 * 8;
constexpr size_t SZ_R1 = (size_t)MTOT * 1024 * 2;
constexpr size_t OFF_R2 = OFF_R1 + SZ_R1;
constexpr size_t SZ_R2 = (size_t)MTOT * DFF * 2;
constexpr size_t OFF_PA = OFF_R2;
constexpr size_t OFF_HYU = OFF_PA + (size_t)MTOT * 640 * 2;
constexpr size_t OFF_HYX = OFF_HYU + (size_t)MTOT * 256 * 2;
constexpr size_t OFF_KR = OFF_HYX + (size_t)MTOT * 256 * 2;
constexpr size_t OFF_PBB = OFF_KR + (size_t)MTOT * 32 * 2;
constexpr size_t OFF_PC = OFF_PBB + (size_t)MTOT * 768 * 2;
constexpr size_t OFF_UPB = OFF_PBB;
constexpr size_t OFF_OBT = OFF_UPB + (size_t)MTOT * 1344 * 2;
constexpr size_t OFF_BAR = OFF_R2 + SZ_R2;
constexpr size_t WS_END = OFF_BAR + (size_t)4096 * 4;
static_assert(OFF_PC + (size_t)MTOT * 416 * 2 <= WS_END, "R2 overflow");
static_assert(OFF_OBT + (size_t)MTOT * 256 * 2 <= OFF_R2 + SZ_R2, "R2 overflow");
static_assert(WS_END <= (size_t)536870912, "workspace too large");

struct Params {
    const float* in[31];
    float* out;
    unsigned char* ws;
    int ph_lo, ph_hi;
};


typedef __attribute__((address_space(4))) const unsigned char* kargp_t;
DI kargp_t karg_base() { kargp_t k = (kargp_t)__builtin_amdgcn_kernarg_segment_ptr(); asm volatile("" : "+s"(k)); return k; }
#define GAS __attribute__((address_space(1)))
DI const float* INP(int i) { const float* q = *(const float* __attribute__((address_space(4))) const*)(karg_base() + 8 * i); return q; }
DI float* OUTP() { float* q = *(float* __attribute__((address_space(4))) const*)(karg_base() + 8 * 31); return q; }
DI unsigned char* WSP() { unsigned char* q = *(unsigned char* __attribute__((address_space(4))) const*)(karg_base() + 8 * 32); return q; }

DI float bf2f(bf16_t b) { return __uint_as_float(((unsigned)b) << 16); }
DI unsigned pack2(float a, float b) { f32x2 v = {a, b}; bf2_t r = __builtin_convertvector(v, bf2_t); return __builtin_bit_cast(unsigned, r); }
DI bf16_t f2bf(float a) { return (bf16_t)(pack2(a, 0.f) & 0xffffu); }
DI float wave_sum(float v) {
#pragma unroll
    for (int o = 32; o > 0; o >>= 1) v += __shfl_xor(v, o);
    return v;
}
DI float fast_exp2(float x) { return __builtin_amdgcn_exp2f(x); }
DI int otid() { int t = threadIdx.x; asm volatile("" : "+v"(t)); return t; }
DI int obid() { int t = blockIdx.x; asm volatile("" : "+s"(t)); return t; }
DI int crow(int reg, int h) { return (reg & 3) + 8 * (reg >> 2) + 4 * h; }
#define MFMA32(a, b, c) __builtin_amdgcn_mfma_f32_32x32x16_bf16((a), (b), (c), 0, 0, 0)

DI void conv_item(const Params& p, int it, LAS unsigned char* lds) {
    LAS float* tile = (LAS float*)lds;
    const int tid = otid();
    const int l = it / 2568; int r = it % 2568;
    int mat, K; size_t woff;
    if (r < 704) { mat = 0; K = 1024; woff = WO_GU1; }
    else if (r < 1056) { r -= 704; mat = 1; K = 2816; woff = WO_D1; }
    else if (r < 1760) { r -= 1056; mat = 2; K = 1024; woff = WO_GU2; }
    else if (r < 2112) { r -= 1760; mat = 3; K = 2816; woff = WO_D2; }
    else if (r < 2368) { r -= 2112; mat = 4; K = 1024; woff = WO_IN; }
    else if (r < 2496) { r -= 2368; mat = 5; K = 1024; woff = WO_OUT; }
    else { r -= 2496; mat = 6; K = 384; woff = WO_UP; }
    const int nK = K / 64, tn = r / nK, tk = r % nK, n0 = tn * 128, k0 = tk * 64;
    bf16_t* dst = (bf16_t*)(WSP() + OFF_W + (size_t)l * SZ_WL + woff);
    {
        const int kk = tid >> 7, n = n0 + (tid & 127);
        const float* sp; const float* sc = nullptr; int ld, klo = 0, khi = K; bool zero = false;
        if (mat == 0 || mat == 2) {
            const int tl_ = n >> 8, c_ = n & 255, bj_ = c_ >> 7, wc_ = (c_ >> 5) & 3, t_ = (c_ >> 4) & 1, fq_ = (c_ >> 2) & 3, j_ = c_ & 3;
            const int unit = tl_ * 128 + wc_ * 32 + fq_ * 8 + bj_ * 4 + j_, col = t_ * 2816 + unit;
            sp = (mat == 0 ? INP(6) : INP(8)) + (size_t)l * 1024 * 5632 + col; ld = 5632;
        } else if (mat == 1 || mat == 3) {
            const int an = (n & ~31) + 8 * ((n & 15) >> 2) + 4 * ((n >> 4) & 1) + (n & 3);
            sp = (mat == 1 ? INP(7) : INP(9)) + (size_t)l * 2816 * 1024 + an; ld = 1024;
        } else if (mat == 4) {
            const int an = (n & ~31) + 8 * ((n & 15) >> 2) + 4 * ((n >> 4) & 1) + (n & 3);
            zero = an >= 1824; sp = INP(12) + (size_t)l * 1024 * 1824 + (zero ? 0 : an); ld = 1824;
        } else if (mat == 5) {
            const int an = (n & ~31) + 8 * ((n & 15) >> 2) + 4 * ((n >> 4) & 1) + (n & 3);
            sp = INP(13) + (size_t)l * 1024 * 1024 + an; ld = 1024;
        } else {
            const int an = (n & ~31) + 8 * ((n & 15) >> 2) + 4 * ((n >> 4) & 1) + (n & 3);
            if (an < 576) { sp = INP(29) + (size_t)l * 256 * 576 + an; ld = 576; khi = 256; sc = INP(27) + l * 256; }
            else if (an < 1344) { sp = INP(30) + (size_t)l * 128 * 768 + (an - 576); ld = 768; klo = 256; sc = INP(28) + l * 128; }
            else { zero = true; sp = INP(29); ld = 0; sc = INP(27); }
        }
        const bool has_sc = (mat == 6);
        float v[16];
#pragma unroll
        for (int ps = 0; ps < 16; ++ps) {
            const int k = k0 + ps * 4 + kk;
            const bool valid = !zero && k >= klo && k < khi;
            const int idx = valid ? k - klo : 0;
            float x = sp[(size_t)idx * ld];
            if (has_sc) x *= sc[idx];
            v[ps] = valid ? x : 0.f;
        }
#pragma unroll
        for (int ps = 0; ps < 16; ++ps) tile[(ps * 4 + kk) * 129 + (tid & 127)] = v[ps];
    }
    __syncthreads();
    {
        const int nl = tid >> 2, kc = (tid & 3) * 16;
#pragma unroll
        for (int hh = 0; hh < 2; ++hh) {
            const int kb = kc + hh * 8;
            u32x4 o;
            o.x = pack2(tile[(kb + 0) * 129 + nl], tile[(kb + 1) * 129 + nl]);
            o.y = pack2(tile[(kb + 2) * 129 + nl], tile[(kb + 3) * 129 + nl]);
            o.z = pack2(tile[(kb + 4) * 129 + nl], tile[(kb + 5) * 129 + nl]);
            o.w = pack2(tile[(kb + 6) * 129 + nl], tile[(kb + 7) * 129 + nl]);
            *(u32x4*)(dst + (size_t)(n0 + nl) * K + k0 + kb) = o;
        }
    }
}

DI void mod_item(const Params& p, int it, LAS unsigned char* lds) {
    LAS float* s = (LAS float*)lds;
    LAS float* red = s + 12 * 1024;
    const int tid = otid();
    const int l = it / 144, jb = it % 144, j0 = jb * 64;
    {
        const float* cvec = INP(1); const float* cctx = INP(3);
        float vv[18];
#pragma unroll
        for (int q = 0; q < 18; ++q) { const int idx = tid + q * NTHR, r = idx >> 10, k = idx & 1023; vv[q] = r < 8 ? cvec[r * 1024 + k] : cctx[k]; }
#pragma unroll
        for (int q = 0; q < 18; ++q) { const int idx = tid + q * NTHR, r = idx >> 10, k = idx & 1023; s[k * 12 + r] = vv[q] / (1.f + __expf(-vv[q])); }
    }
    __syncthreads();
    const int jc = tid & 63, kg = tid >> 6;
    const float* w = INP(4) + (size_t)l * 1024 * 9216 + j0 + jc;
    float acc[9];
#pragma unroll
    for (int r = 0; r < 9; ++r) acc[r] = 0.f;
#pragma unroll 16
    for (int k = kg * 128; k < kg * 128 + 128; ++k) {
        const float wv = w[(size_t)k * 9216];
        const f32x4 s0 = *(const LAS f32x4*)(s + k * 12), s1 = *(const LAS f32x4*)(s + k * 12 + 4); const float s8 = s[k * 12 + 8];
        acc[0] += s0[0] * wv; acc[1] += s0[1] * wv; acc[2] += s0[2] * wv; acc[3] += s0[3] * wv;
        acc[4] += s1[0] * wv; acc[5] += s1[1] * wv; acc[6] += s1[2] * wv; acc[7] += s1[3] * wv; acc[8] += s8 * wv;
    }
#pragma unroll
    for (int r = 0; r < 9; ++r) red[(kg * 9 + r) * 64 + jc] = acc[r];
    __syncthreads();
    float* mod = (float*)(WSP() + OFF_MOD) + (size_t)l * 9 * 9216;
    const float* adab = INP(5);
    for (int idx = tid; idx < 9 * 64; idx += NTHR) {
        const int r = idx >> 6, c = idx & 63;
        float v = adab[l * 9216 + j0 + c];
#pragma unroll
        for (int g = 0; g < 8; ++g) v += red[(g * 9 + r) * 64 + c];
        mod[(size_t)r * 9216 + j0 + c] = v;
    }
}

DI void filt_item(const Params& p, int it, LAS unsigned char* lds) {
    const int tid = otid();
    const int l = it / 136; int r = it % 136;
    const int which = r < 128 ? 0 : 1; if (which) r -= 128;
    const int n = which ? 256 : 4096, t0 = r * 32;
    LAS float* z = (LAS float*)lds;
    LAS float* hA = z + 32 * 33;
    LAS float* hB = hA + 32 * 64;
    LAS bf16_t* ot = (LAS bf16_t*)(hB + 32 * 64);
    for (int idx = tid; idx < 32 * 33; idx += NTHR) {
        const int tt = idx / 33, e = idx % 33, ti = t0 + tt;
        float v;
        if (e == 0) v = (float)ti / (float)(n - 1);
        else {
            const int j = (e - 1) & 15;
            const float f = 1e-4f + (float)j * ((15.f - 1e-4f) / 15.f);
            const float w = 6.283185307179586f * (float)ti / (float)n;
            const float a = f * w;
            v = e <= 16 ? cosf(a) : -sinf(a);
        }
        z[idx] = v;
    }
    __syncthreads();
    const float* W1 = INP(18) + l * 33 * 64; const float* B1 = INP(19) + l * 64;
    const float* W2 = INP(20) + l * 64 * 64; const float* B2 = INP(21) + l * 64;
    const float* W3 = INP(22) + l * 64 * 64; const float* B3 = INP(23) + l * 64;
    const float* W4 = INP(24) + l * 64 * 512; const float* FR = INP(25) + l * 64;
    {
        const int j = tid & 63, t8 = tid >> 6;
        float a[4];
#pragma unroll
        for (int q = 0; q < 4; ++q) a[q] = B1[j];
#pragma unroll 11
        for (int e = 0; e < 33; ++e) { const float wv = W1[e * 64 + j];
#pragma unroll
            for (int q = 0; q < 4; ++q) a[q] += z[(t8 + 8 * q) * 33 + e] * wv; }
        const float fr = FR[j];
#pragma unroll
        for (int q = 0; q < 4; ++q) hA[(t8 + 8 * q) * 64 + j] = sinf(fr * a[q]);
        __syncthreads();
#pragma unroll
        for (int q = 0; q < 4; ++q) a[q] = B2[j];
#pragma unroll 16
        for (int e = 0; e < 64; ++e) { const float wv = W2[e * 64 + j];
#pragma unroll
            for (int q = 0; q < 4; ++q) a[q] += hA[(t8 + 8 * q) * 64 + e] * wv; }
#pragma unroll
        for (int q = 0; q < 4; ++q) hB[(t8 + 8 * q) * 64 + j] = sinf(fr * a[q]);
        __syncthreads();
#pragma unroll
        for (int q = 0; q < 4; ++q) a[q] = B3[j];
#pragma unroll 16
        for (int e = 0; e < 64; ++e) { const float wv = W3[e * 64 + j];
#pragma unroll
            for (int q = 0; q < 4; ++q) a[q] += hB[(t8 + 8 * q) * 64 + e] * wv; }
#pragma unroll
        for (int q = 0; q < 4; ++q) hA[(t8 + 8 * q) * 64 + j] = sinf(fr * a[q]);
        __syncthreads();
    }
    {
        const int col = tid, c = col & 255;
        const float a0 = -3.0701134573253942f, a1 = -15.350567286626972f;
        const float delta = fabsf(a0 + (float)c * ((a1 - a0) / 255.f));
        float part = 0.f;
        float w4r[64];
#pragma unroll
        for (int e = 0; e < 64; ++e) w4r[e] = W4[e * 512 + col];
#pragma unroll 1
        for (int tt = 0; tt < 32; ++tt) {
            float a = 0.f;
#pragma unroll
            for (int e = 0; e < 64; e += 4) { const f32x4 hv = *(const LAS f32x4*)(hA + tt * 64 + e);
                a += hv[0] * w4r[e] + hv[1] * w4r[e + 1] + hv[2] * w4r[e + 2] + hv[3] * w4r[e + 3]; }
            const int ti = t0 + tt;
            const float tl = (float)ti / (float)(n - 1);
            float v = a * __expf(-tl * delta);
            if (col >= 256 && ti == 0) v = 0.f;
            part += fabsf(v);
            ot[col * 32 + tt] = f2bf(v);
        }
        float* pp = which ? (float*)(WSP() + OFF_PARTC) + ((size_t)l * 8 + r) * 512 : (float*)(WSP() + OFF_PART) + ((size_t)l * 128 + r) * 512;
        pp[col] = part;
    }
    __syncthreads();
    bf16_t* kf = which ? (bf16_t*)(WSP() + OFF_KFC) + (size_t)l * 256 * 512 : (bf16_t*)(WSP() + OFF_KF) + (size_t)l * 256 * 8192;
    for (int idx = tid; idx < 512 * 32; idx += NTHR) {
        const int col = idx >> 5, tt = idx & 31, ti = t0 + tt, c = col & 255;
        const bf16_t v = ot[col * 32 + tt];
        if (col < 256) kf[(size_t)c * (2 * n) + n + ti] = v;
        else if (ti == 0) kf[(size_t)c * (2 * n)] = 0;
        else kf[(size_t)c * (2 * n) + n - ti] = v;
    }
}

DI void rope_item(const Params& p, int it) {
    const int e = it * NTHR + otid();
    const int pos = e / 48, a = e % 48;
    const int row = pos >> 6, col = pos & 63;
    float inv, coord;
    if (a < 32) { const int f = a & 15; inv = powf(10000.f, -(float)f / 16.f); coord = (float)(a < 16 ? row : col); }
    else { const int a2 = a - 32, f = a2 & 7; inv = powf(10000.f, -(float)f / 8.f); coord = (float)(a2 < 8 ? row : col); }
    const float ang = coord * inv;
    f32x2 cs = {cosf(ang), sinf(ang)};
    ((f32x2*)(WSP() + OFF_ROPE))[e] = cs;
}

#ifndef PPROBE
#define PPROBE 0
#endif
DI void phase_p0a(const Params& p, LAS unsigned char* lds) {
    constexpr int NMODI = 288, NFILT = 272, NROPE = 384, NCONV = 2 * 2568;
    constexpr int TOTAL = NMODI + NFILT + NROPE + NCONV;
    for (int it = obid(); it < TOTAL; it += gridDim.x) {
        unsigned long long pt0_ = 0; if (PPROBE) pt0_ = __builtin_amdgcn_s_memrealtime();
        if (it < NMODI) mod_item(p, it, lds);
        else if (it < NMODI + NFILT) filt_item(p, it - NMODI, lds);
        else if (it < NMODI + NFILT + NROPE) rope_item(p, it - NMODI - NFILT);
        else conv_item(p, it - NMODI - NFILT - NROPE, lds);
        __syncthreads();
        if (PPROBE) { const int ty = it < NMODI ? 1 : (it < NMODI + NFILT ? 2 : (it < NMODI + NFILT + NROPE ? 4 : 8));
            if ((PPROBE & ty) && threadIdx.x == 0) *(LAS unsigned long long*)(lds + LDS_BYTES - 32) += __builtin_amdgcn_s_memrealtime() - pt0_; }
    }
}

DI void phase_ln(const Params& p, int M, bool first, const float* g, const float* bta, bool do_mod, int lmod, int i_shift, int i_scale, bool write_out, int row0 = 0, int vb0 = 0, int vG = 0, const bf16_t* Yd = nullptr, bool from_in = false) {
    const int tid_ = otid(); const int lane = tid_ & 63, wv = tid_ >> 6;
    float* X = (float*)(WSP() + OFF_X);
    bf16_t* H = (bf16_t*)(WSP() + OFF_R1);
    const float* mod = (const float*)(WSP() + OFF_MOD) + (size_t)lmod * 9 * 9216;
    const int Gl = vG > 0 ? vG : (int)gridDim.x, vbl = obid() - vb0;
    if (vbl < 0 || vbl >= Gl) return;
    const bool rd_in = first || from_in;
    const float* xin = rd_in ? INP(0) : nullptr; const float* cin = rd_in ? INP(2) : nullptr;
    const float in_sc = from_in ? ALPHA : 1.f;
#define LN_LOAD(r, dst) do { const float* src_ = rd_in ? ((r) < MLAT ? xin + (size_t)(r) * D : cin + (size_t)((r) - MLAT) * D) : X + (size_t)(r) * D; \
        _Pragma("unroll") for (int q = 0; q < 4; ++q) dst[q] = in_sc * *(const f32x4*)(src_ + q * 256 + lane * 4); \
        if (Yd != nullptr) { _Pragma("unroll") for (int q = 0; q < 4; ++q) { const u32x2 y_ = *(const u32x2*)(Yd + (size_t)(r) * D + q * 256 + lane * 4); \
            dst[q] = dst[q] + (f32x4){__uint_as_float(y_.x << 16), __uint_as_float(y_.x & 0xffff0000u), __uint_as_float(y_.y << 16), __uint_as_float(y_.y & 0xffff0000u)}; } } } while (0)
    const int rstep = Gl * 8;
    f32x4 gg4[4], bb4[4];
#pragma unroll
    for (int q = 0; q < 4; ++q) { gg4[q] = (f32x4){1.f, 1.f, 1.f, 1.f}; bb4[q] = (f32x4){0.f, 0.f, 0.f, 0.f}; }
    if (!first) {
#pragma unroll
        for (int q = 0; q < 4; ++q) { gg4[q] = *(const f32x4*)(g + q * 256 + lane * 4); bb4[q] = *(const f32x4*)(bta + q * 256 + lane * 4); }
    }
    f32x4 v[4], vn[4];
    { const int r0_ = row0 + vbl * 8 + wv; if (r0_ < M) LN_LOAD(r0_, v); }
    for (int row = row0 + vbl * 8 + wv; row < M; row += rstep) {
        const bool more = row + rstep < M;
        if (more) LN_LOAD(row + rstep, vn);
        f32x4 sc4[4], sh4[4];
        if (do_mod) {
            const int bi_ = row < MLAT ? (row >> 12) : 8;
            const float* sh_ = mod + (size_t)bi_ * 9216 + i_shift * 1024; const float* sc_ = mod + (size_t)bi_ * 9216 + i_scale * 1024;
#pragma unroll
            for (int q = 0; q < 4; ++q) { sc4[q] = *(const f32x4*)(sc_ + q * 256 + lane * 4); sh4[q] = *(const f32x4*)(sh_ + q * 256 + lane * 4); }
        }
        if (!first) {
            float s = 0.f;
#pragma unroll
            for (int q = 0; q < 4; ++q) s += (v[q][0] + v[q][1]) + (v[q][2] + v[q][3]);
            const float mu = wave_sum(s) * (1.f / 1024.f);
            float ss = 0.f;
#pragma unroll
            for (int q = 0; q < 4; ++q) { const f32x4 d = v[q] - mu; ss += (d[0] * d[0] + d[1] * d[1]) + (d[2] * d[2] + d[3] * d[3]); }
            const float rstd = rsqrtf(wave_sum(ss) * (1.f / 1024.f) + EPS);
#pragma unroll
            for (int q = 0; q < 4; ++q) {
                v[q] = (v[q] - mu) * rstd * gg4[q] + bb4[q];
            }
        }
#pragma unroll
        for (int q = 0; q < 4; ++q) if (!write_out && !first) *(f32x4*)(X + (size_t)row * D + q * 256 + lane * 4) = ALPHA * v[q];
        if (write_out && row < MLAT) {
#pragma unroll
            for (int q = 0; q < 4; ++q) *(f32x4*)(OUTP() + (size_t)row * D + q * 256 + lane * 4) = v[q];
        }
        if (do_mod) {
            float s = 0.f;
#pragma unroll
            for (int q = 0; q < 4; ++q) s += (v[q][0] + v[q][1]) + (v[q][2] + v[q][3]);
            const float mu = wave_sum(s) * (1.f / 1024.f);
            float ss = 0.f;
#pragma unroll
            for (int q = 0; q < 4; ++q) { const f32x4 d = v[q] - mu; ss += (d[0] * d[0] + d[1] * d[1]) + (d[2] * d[2] + d[3] * d[3]); }
            const float rstd = rsqrtf(wave_sum(ss) * (1.f / 1024.f) + EPS);
#pragma unroll
            for (int q = 0; q < 4; ++q) {
                const f32x4 s4 = sc4[q], h4 = sh4[q];
                const f32x4 o = (v[q] - mu) * rstd * (1.f + s4) + h4;
                u32x2 w; w.x = pack2(o[0], o[1]); w.y = pack2(o[2], o[3]);
                *(u32x2*)(H + (size_t)row * D + q * 256 + lane * 4) = w;
            }
        }
        if (more) {
#pragma unroll
            for (int q = 0; q < 4; ++q) v[q] = vn[q];
        }
    }
#undef LN_LOAD
}

namespace gm {
constexpr int BM = 256, BK = 64, HALF = 128, HTB = HALF * BK * 2, NXCD = 8, WGM = 8;
DI int lds_byte(int r, int c) { const int st = (r >> 4) * 2 + (c >> 5), rr = r & 15, cc = c & 31, ob = rr * 64 + cc * 2; return st * 1024 + (ob ^ (((ob >> 9) & 1) << 5)); }
DI void stage_rc(int b, int& R, int& C) { const int st = b / 1024, sb = b % 1024, swz = sb ^ (((sb >> 9) & 1) << 5); R = (st >> 1) * 16 + swz / 64; C = (st & 1) * 32 + (swz % 64) / 2; }

struct EpiSwiglu {
    static constexpr bool SPLITK = false;
    bf16_t* act;
    DI void operator()(const f32x4 (&acc)[2][2][4][2], int pm, int pn, int wr, int wc, int fr, int fq, bool) const {
        const int unit0 = pn * 128 + wc * 32 + fq * 8;
#pragma unroll
        for (int ai = 0; ai < 2; ++ai)
#pragma unroll
            for (int m = 0; m < 4; ++m) {
                const int row = pm * 256 + ai * 128 + wr * 64 + m * 16 + fr;
                float o[8];
#pragma unroll
                for (int bj = 0; bj < 2; ++bj) {
                    const f32x4 gt = acc[ai][bj][m][0], up = acc[ai][bj][m][1];
#pragma unroll
                    for (int j = 0; j < 4; ++j) o[bj * 4 + j] = gt[j] * __builtin_amdgcn_rcpf(1.f + __expf(-gt[j])) * up[j];
                }
                u32x4 w; w.x = pack2(o[0], o[1]); w.y = pack2(o[2], o[3]); w.z = pack2(o[4], o[5]); w.w = pack2(o[6], o[7]);
                *(u32x4*)(act + (size_t)row * DFF + unit0) = w;
            }
    }
};
struct EpiResid {
    static constexpr bool SPLITK = false;
    bf16_t* Y; const float* gate; float coef;
    DI void operator()(const f32x4 (&acc)[2][2][4][2], int pm, int pn, int wr, int wc, int fr, int fq, bool) const {
        const int row0 = pm * 256 + wr * 64 + fr;
        const int bi = row0 < MLAT ? (row0 >> 12) : 8;
        const int col0 = pn * 256 + wc * 32 + fq * 8;
        f32x4 gv[2][2];
#pragma unroll
        for (int bj = 0; bj < 2; ++bj)
#pragma unroll
            for (int n = 0; n < 2; ++n) gv[bj][n] = coef * *(const f32x4*)(gate + (size_t)bi * 9216 + col0 + bj * 128 + n * 4);
#pragma unroll
        for (int ai = 0; ai < 2; ++ai)
#pragma unroll
            for (int m = 0; m < 4; ++m) {
                bf16_t* yp = Y + (size_t)(row0 + ai * 128 + m * 16) * D + col0;
#pragma unroll
                for (int bj = 0; bj < 2; ++bj) {
                    const f32x4 a = gv[bj][0] * acc[ai][bj][m][0], b = gv[bj][1] * acc[ai][bj][m][1];
                    u32x4 w; w.x = pack2(a[0], a[1]); w.y = pack2(a[2], a[3]); w.z = pack2(b[0], b[1]); w.w = pack2(b[2], b[3]);
                    *(u32x4*)(yp + bj * 128) = w;
                }
            }
    }
};
struct EpiWin {
    static constexpr bool SPLITK = false;
    bf16_t* pa; bf16_t* pbb; bf16_t* pc;
    DI void operator()(const f32x4 (&acc)[2][2][4][2], int pm, int pn, int wr, int wc, int fr, int fq, bool) const {
#pragma unroll
        for (int ai = 0; ai < 2; ++ai)
#pragma unroll
            for (int m = 0; m < 4; ++m) {
                const int row = pm * 256 + ai * 128 + wr * 64 + m * 16 + fr;
#pragma unroll
                for (int bj = 0; bj < 2; ++bj) {
                    const int col = pn * 256 + bj * 128 + wc * 32 + fq * 8;
                    const f32x4 a = acc[ai][bj][m][0], b = acc[ai][bj][m][1];
                    u32x4 w; w.x = pack2(a[0], a[1]); w.y = pack2(a[2], a[3]); w.z = pack2(b[0], b[1]); w.w = pack2(b[2], b[3]);
                    if (col < 640) *(u32x4*)(pa + (size_t)row * 640 + col) = w;
                    else if (col < 1408) *(u32x4*)(pbb + (size_t)row * 768 + (col - 640)) = w;
                    else if (col < 1824) *(u32x4*)(pc + (size_t)row * 416 + (col - 1408)) = w;
                }
            }
    }
};
struct EpiUp {
    static constexpr bool SPLITK = false;
    bf16_t* upb; float qscale;
    DI void operator()(const f32x4 (&acc)[2][2][4][2], int pm, int pn, int wr, int wc, int fr, int fq, bool) const {
#pragma unroll
        for (int ai = 0; ai < 2; ++ai)
#pragma unroll
            for (int m = 0; m < 4; ++m) {
                const int row = pm * 256 + ai * 128 + wr * 64 + m * 16 + fr;
#pragma unroll
                for (int bj = 0; bj < 2; ++bj) {
                    const int col = pn * 256 + bj * 128 + wc * 32 + fq * 8;
                    if (col < 1344) {
                        const float sc = col < 576 ? qscale : 1.f;
                        const f32x4 a = acc[ai][bj][m][0] * sc, b = acc[ai][bj][m][1] * sc;
                        u32x4 w; w.x = pack2(a[0], a[1]); w.y = pack2(a[2], a[3]); w.z = pack2(b[0], b[1]); w.w = pack2(b[2], b[3]);
                        *(u32x4*)(upb + (size_t)row * 1344 + col) = w;
                    }
                }
            }
    }
};

#define G_SA(b, h) (((b) * 2 + (h)) * HTB)
#define G_SB(b, h) ((4 + (b) * 2 + (h)) * HTB)
#define G_STAGE(bufoff, gbase, voff) do { _Pragma("unroll") for (int _i = 0; _i < 2; ++_i) \
        __builtin_amdgcn_global_load_lds((const unsigned*)((const char*)(gbase) + (voff)[_i]), (LAS unsigned*)(lds + (bufoff) + ldsw + _i * 8192), 16, 0, 0); } while (0)
#define G_LDA(dst, b, h) do { _Pragma("unroll") for (int m = 0; m < 4; ++m) _Pragma("unroll") for (int k = 0; k < 2; ++k) dst[m][k] = *(const LAS bf16x8*)(lds + G_SA(b, h) + aoff + m * 2048 + k * 1024); } while (0)
#define G_LDB(dst, b, h) do { _Pragma("unroll") for (int n = 0; n < 2; ++n) _Pragma("unroll") for (int k = 0; k < 2; ++k) dst[n][k] = *(const LAS bf16x8*)(lds + G_SB(b, h) + boff + n * 2048 + k * 1024); } while (0)
#define G_MMA(ai, bj, At, Bt) do { __builtin_amdgcn_s_setprio(1); _Pragma("unroll") for (int m = 0; m < 4; ++m) _Pragma("unroll") for (int n = 0; n < 2; ++n) _Pragma("unroll") for (int k = 0; k < 2; ++k) \
        acc[ai][bj][m][n] = __builtin_amdgcn_mfma_f32_16x16x32_bf16(Bt[n][k], At[m][k], acc[ai][bj][m][n], 0, 0, 0); __builtin_amdgcn_s_setprio(0); } while (0)
#define G_WAIT_V(n) asm volatile("s_waitcnt vmcnt(" #n ")" ::: "memory")
#define G_WAIT_L(n) asm volatile("s_waitcnt lgkmcnt(" #n ")" ::: "memory")
#define G_BAR __builtin_amdgcn_s_barrier()
#define G_SCHED __builtin_amdgcn_sched_barrier(0)

template <class Epi>
DI void gemm_phase(LAS unsigned char* lds, const bf16_t* A, int lda, const bf16_t* Bt, int ldb, int M, int N, int K, const Epi& epi, int pm0 = 0, int vb0 = 0, int vG = 0) {
    const int tid = otid(), wid = __builtin_amdgcn_readfirstlane(tid >> 6), lane = tid & 63, wr = wid >> 2, wc = wid & 3, fr = lane & 15, fq = lane >> 4;
    const int nt = K / BK, nM = M / BM, nN = N / BM, nwg = nM * nN;
    const int G = vG > 0 ? vG : (int)gridDim.x;
    const int vb = obid() - vb0;
    if (vb < 0 || vb >= G || vb >= nwg) return;
    unsigned voffA[2], voffB[2];
#pragma unroll
    for (int i = 0; i < 2; ++i) { int R, C; stage_rc(tid * 16 + i * 8192, R, C); voffA[i] = (unsigned)(R * lda + C) * 2u; voffB[i] = (unsigned)(R * ldb + C) * 2u; }
    const unsigned ldsw = (unsigned)wid * 1024u;
    const int aoff = lds_byte(wr * 64 + fr, fq * 8), boff = lds_byte(wc * 32 + fr, fq * 8);
    const size_t kstep = (size_t)(BK * 2), hA = (size_t)HALF * lda * 2, hB = (size_t)HALF * ldb * 2;
#define G_COORDS(Lx, pmx, pnx) do { int wgid = (Lx); \
        { const int q = nwg / NXCD, r = nwg % NXCD, xcd = wgid % NXCD, off = wgid / NXCD; wgid = (xcd < r ? xcd * (q + 1) : r * (q + 1) + (xcd - r) * q) + off; } \
        const int nig = WGM * nN, gid = wgid / nig, fm = gid * WGM, gsz = (nM - fm) < WGM ? (nM - fm) : WGM; \
        pmx = pm0 + fm + ((wgid % nig) % gsz); pnx = (wgid % nig) / gsz; } while (0)
    int pm, pn; G_COORDS(vb, pm, pn);
    const char* cA = (const char*)(A + (size_t)pm * BM * lda);
    const char* cB = (const char*)(Bt + (size_t)pn * BM * ldb);
    f32x4 acc[2][2][4][2];
#pragma unroll
    for (int a = 0; a < 2; ++a)
#pragma unroll
        for (int b = 0; b < 2; ++b)
#pragma unroll
            for (int m = 0; m < 4; ++m)
#pragma unroll
                for (int n = 0; n < 2; ++n) acc[a][b][m][n] = (f32x4){0.f, 0.f, 0.f, 0.f};
    bf16x8 At[4][2], B0[2][2], B1[2][2];
    G_STAGE(G_SB(0, 0), cB, voffB); G_STAGE(G_SB(0, 1), cB + hB, voffB); G_STAGE(G_SA(0, 0), cA, voffA); G_STAGE(G_SA(0, 1), cA + hA, voffA);
    if (wr == 1) G_BAR;
    G_WAIT_V(2); G_BAR;
    G_STAGE(G_SB(1, 0), cB + kstep, voffB); G_STAGE(G_SA(1, 0), cA + kstep, voffA); G_STAGE(G_SB(1, 1), cB + hB + kstep, voffB);
    G_WAIT_V(6); G_BAR;
    for (int wu = vb;;) {
        const int wn = wu + G;
        const bool has_next = wn < nwg;
        int pmn = pm, pnn = pn;
        if (has_next) G_COORDS(wn, pmn, pnn);
        const char* nA = has_next ? (const char*)(A + (size_t)pmn * BM * lda) : cA;
        const char* nB = has_next ? (const char*)(Bt + (size_t)pnn * BM * ldb) : cB;
        for (int t = 0; t < nt; t += 2) {
            const bool last = (t == nt - 2);
            const char* a1 = cA + (size_t)(t + 1) * kstep;
            const char* a2 = last ? nA : cA + (size_t)(t + 2) * kstep; const char* b2 = last ? nB : cB + (size_t)(t + 2) * kstep;
            const char* a3 = a2 + kstep; const char* b3 = b2 + kstep;
            G_LDB(B0, 0, 0); G_LDB(B1, 0, 1); G_SCHED; G_LDA(At, 0, 0); G_STAGE(G_SA(1, 1), a1 + hA, voffA);
            G_WAIT_V(8); G_WAIT_L(0); G_BAR; G_MMA(0, 0, At, B0); G_MMA(0, 1, At, B1); G_BAR; G_SCHED;
            G_LDA(At, 0, 1); G_STAGE(G_SB(0, 0), b2, voffB); G_STAGE(G_SB(0, 1), b2 + hB, voffB); G_STAGE(G_SA(0, 0), a2, voffA);
            G_WAIT_V(8); G_WAIT_L(0); G_BAR; G_MMA(1, 0, At, B0); G_MMA(1, 1, At, B1); G_BAR; G_SCHED;
            G_LDB(B0, 1, 0); G_LDB(B1, 1, 1); G_SCHED; G_LDA(At, 1, 0); G_STAGE(G_SA(0, 1), a2 + hA, voffA);
            G_WAIT_V(8); G_WAIT_L(0); G_BAR; G_MMA(0, 0, At, B0); G_MMA(0, 1, At, B1); G_BAR; G_SCHED;
            G_LDA(At, 1, 1); G_STAGE(G_SB(1, 0), b3, voffB); G_STAGE(G_SB(1, 1), b3 + hB, voffB); G_STAGE(G_SA(1, 0), a3, voffA);
            G_WAIT_V(8); G_WAIT_L(0); G_BAR; G_MMA(1, 0, At, B0); G_MMA(1, 1, At, B1); G_BAR; G_SCHED;
        }
        if (wr == 0) G_BAR;
        epi(acc, pm, pn, wr, wc, fr, fq, false);
        if (!has_next) break;
#pragma unroll
        for (int a = 0; a < 2; ++a)
#pragma unroll
            for (int b = 0; b < 2; ++b)
#pragma unroll
                for (int m = 0; m < 4; ++m)
#pragma unroll
                    for (int n = 0; n < 2; ++n) acc[a][b][m][n] = (f32x4){0.f, 0.f, 0.f, 0.f};
        pm = pmn; pn = pnn; cA = nA; cB = nB; wu = wn;
        if (wr == 1) G_BAR;
    }
    G_WAIT_V(0);
    G_BAR;
#undef G_COORDS
    __syncthreads();
}
}


DI void phase_post(const Params& p, int l, LAS unsigned char* lds) {
    const int tid_ = otid(); const int lane = tid_ & 63, wv = tid_ >> 6;
    bf16_t* PA = (bf16_t*)(WSP() + OFF_PA);
    const bf16_t* PBB = (const bf16_t*)(WSP() + OFF_PBB);
    const bf16_t* PC = (const bf16_t*)(WSP() + OFF_PC);
    bf16_t* HYU = (bf16_t*)(WSP() + OFF_HYU);
    bf16_t* HYX = (bf16_t*)(WSP() + OFF_HYX);
    bf16_t* KR = (bf16_t*)(WSP() + OFF_KR);
    bf16_t* CN = (bf16_t*)(WSP() + OFF_R1);
    const f32x2* ROPE = (const f32x2*)(WSP() + OFF_ROPE);
    const int hd = lane >> 3, e0 = (lane & 7) * 8;
    float g8[8];
#pragma unroll
    for (int j = 0; j < 8; ++j) g8[j] = (hd < 6 ? INP(14)[l * 64 + e0 + j] : INP(15)[l * 64 + e0 + j]) * (hd < 6 ? 0.125f * LOG2E : 1.f);
    const float* cw = INP(16) + (size_t)l * 3 * 768;
    const float* cb = INP(17) + (size_t)l * 768;
    f32x4 w0[3], w1[3], w2[3], wb[3];
#pragma unroll
    for (int g3 = 0; g3 < 3; ++g3) {
        const int col = g3 * 256 + 4 * lane;
        w0[g3] = *(const f32x4*)(cw + col); w1[g3] = *(const f32x4*)(cw + 768 + col); w2[g3] = *(const f32x4*)(cw + 1536 + col); wb[g3] = *(const f32x4*)(cb + col);
    }
    LAS bf16_t* UT = (LAS bf16_t*)lds;
    LAS bf16_t* XT = UT + 256 * 40;
    for (int tile = obid(); tile < MTOT / 32; tile += gridDim.x) {
      for (int tq = 0; tq < 4; ++tq) {
        const int tt = wv * 4 + tq, tok = tile * 32 + tt;
        const bool lat = tok < MLAT;
        const int t = lat ? (tok & 4095) : ((tok - MLAT) & 255);
        const int n = lat ? SEQ : CTXL;
        bf16_t* pa = PA + (size_t)tok * 640 + lane * 8;
        const u32x4 raw = *(const u32x4*)pa;
        const bf16_t* r0 = PBB + (size_t)tok * 768 + 4 * lane;
        u32x2 c0v[3], cmv[3], cpv[3];
#pragma unroll
        for (int g3 = 0; g3 < 3; ++g3) {
            c0v[g3] = *(const u32x2*)(r0 + g3 * 256);
            cmv[g3] = (u32x2){0u, 0u}; cpv[g3] = (u32x2){0u, 0u};
            if (t > 0) cmv[g3] = *(const u32x2*)(r0 + g3 * 256 - 768);
            if (t < n - 1) cpv[g3] = *(const u32x2*)(r0 + g3 * 256 + 768);
        }
        const bf16_t* pc = PC + (size_t)tok * 416;
        const u32x2 cq = *(const u32x2*)(pc + 4 * lane);
        const unsigned ck = *(const unsigned*)(pc + 256 + 2 * lane);
        const bf16_t krraw = pc[384 + (lane & 31)];
        f32x2 csa[8]; f32x2 csk = {1.f, 0.f};
        if (lat) {
            const f32x2* cs = ROPE + (size_t)t * 48 + (lane & 3) * 8;
#pragma unroll
            for (int j = 0; j < 8; ++j) csa[j] = cs[j];
            csk = ROPE[(size_t)t * 48 + 32 + (lane & 15)];
        }
        {
            float x[8];
#pragma unroll
            for (int j = 0; j < 4; ++j) { x[2 * j] = __uint_as_float(raw[j] << 16); x[2 * j + 1] = __uint_as_float(raw[j] & 0xffff0000u); }
            float ss = 0.f;
#pragma unroll
            for (int j = 0; j < 8; ++j) ss += x[j] * x[j];
            ss += __shfl_xor(ss, 1); ss += __shfl_xor(ss, 2); ss += __shfl_xor(ss, 4);
            const float r = rsqrtf(ss * (1.f / 64.f) + EPS);
#pragma unroll
            for (int j = 0; j < 8; ++j) x[j] *= r * g8[j];
            if (lat) {
#pragma unroll
                for (int j = 0; j < 8; ++j) {
                    const float pr = __shfl_xor(x[j], 4);
                    const f32x2 c = csa[j];
                    x[j] = (lane & 4) ? x[j] * c[0] + pr * c[1] : x[j] * c[0] - pr * c[1];
                }
            }
            u32x4 o; o.x = pack2(x[0], x[1]); o.y = pack2(x[2], x[3]); o.z = pack2(x[4], x[5]); o.w = pack2(x[6], x[7]);
            *(u32x4*)pa = o;
        }
        {
            f32x4 o[3];
#pragma unroll
            for (int g3 = 0; g3 < 3; ++g3) {
                const u32x2 c0 = c0v[g3], cm = cmv[g3], cp = cpv[g3];
                const f32x4 vm = {__uint_as_float(cm.x << 16), __uint_as_float(cm.x & 0xffff0000u), __uint_as_float(cm.y << 16), __uint_as_float(cm.y & 0xffff0000u)};
                const f32x4 v0 = {__uint_as_float(c0.x << 16), __uint_as_float(c0.x & 0xffff0000u), __uint_as_float(c0.y << 16), __uint_as_float(c0.y & 0xffff0000u)};
                const f32x4 vp = {__uint_as_float(cp.x << 16), __uint_as_float(cp.x & 0xffff0000u), __uint_as_float(cp.y << 16), __uint_as_float(cp.y & 0xffff0000u)};
                o[g3] = w0[g3] * vm + w1[g3] * v0 + w2[g3] * vp + wb[g3];
            }
            const f32x4 u = o[0] * o[1];
            u32x2 a; a.x = pack2(u[0], u[1]); a.y = pack2(u[2], u[3]);
            u32x2 b; b.x = pack2(o[2][0], o[2][1]); b.y = pack2(o[2][2], o[2][3]);
#pragma unroll
            for (int j = 0; j < 4; ++j) {
                const unsigned ua = (j & 1) ? ((j < 2 ? a.x : a.y) >> 16) : ((j < 2 ? a.x : a.y) & 0xffffu);
                const unsigned ub = (j & 1) ? ((j < 2 ? b.x : b.y) >> 16) : ((j < 2 ? b.x : b.y) & 0xffffu);
                UT[(4 * lane + j) * 40 + tt] = (bf16_t)ua; XT[(4 * lane + j) * 40 + tt] = (bf16_t)ub;
            }
        }
        {
            const f32x4 v = {__uint_as_float(cq.x << 16), __uint_as_float(cq.x & 0xffff0000u), __uint_as_float(cq.y << 16), __uint_as_float(cq.y & 0xffff0000u)};
            const float rq = rsqrtf(wave_sum((v[0] * v[0] + v[1] * v[1]) + (v[2] * v[2] + v[3] * v[3])) * (1.f / 256.f) + EPS);
            u32x2 oq; oq.x = pack2(v[0] * rq, v[1] * rq); oq.y = pack2(v[2] * rq, v[3] * rq);
            *(u32x2*)(CN + (size_t)tok * 384 + 4 * lane) = oq;
            const float u0 = __uint_as_float(ck << 16), u1 = __uint_as_float(ck & 0xffff0000u);
            const float rk = rsqrtf(wave_sum(u0 * u0 + u1 * u1) * (1.f / 128.f) + EPS);
            *(unsigned*)(CN + (size_t)tok * 384 + 256 + 2 * lane) = pack2(u0 * rk, u1 * rk);
            float kr = bf2f(krraw);
            const float pr = __shfl_xor(kr, 16);
            if (lat) kr = (lane & 16) ? kr * csk[0] + pr * csk[1] : kr * csk[0] - pr * csk[1];
            if (lane < 32) KR[(size_t)tok * 32 + lane] = f2bf(kr);
        }
      }
      __syncthreads();
      {
          const int ch = tid_ >> 1, half = tid_ & 1;
          const u32x4 u0 = *(const LAS u32x4*)(UT + ch * 40 + 16 * half), u1 = *(const LAS u32x4*)(UT + ch * 40 + 16 * half + 8);
          const u32x4 x0 = *(const LAS u32x4*)(XT + ch * 40 + 16 * half), x1 = *(const LAS u32x4*)(XT + ch * 40 + 16 * half + 8);
          bf16_t* du = HYU + (size_t)ch * MTOT + tile * 32 + 16 * half; bf16_t* dx = HYX + (size_t)ch * MTOT + tile * 32 + 16 * half;
          *(u32x4*)du = u0; *(u32x4*)(du + 8) = u1; *(u32x4*)dx = x0; *(u32x4*)(dx + 8) = x1;
      }
      __syncthreads();
    }
}

template <int DQK>
DI void attn_item(LAS unsigned char* lds, const bf16_t* qbase, int q_ld, const bf16_t* kc, const bf16_t* kl, const bf16_t* vc, const bf16_t* vl, int kv_ld,
                  const bf16_t* krc, const bf16_t* krl, int ntiles, bf16_t* obase, const f32x2* rope) {
    constexpr int KS = DQK + 8, VS = 68, KBYTES = 64 * KS * 2, BUF = KBYTES + 64 * VS * 2, NKK = DQK / 16;
    const int tid = otid(), lane = tid & 63, w = tid >> 6, li = lane & 31, h = lane >> 5;
    bf16x8 qf[NKK];
    {
        const bf16_t* qrow = qbase + (size_t)(32 * w + li) * q_ld;
#pragma unroll
        for (int kk = 0; kk < NKK; ++kk) qf[kk] = *(const bf16x8*)(qrow + 16 * kk + 8 * h);
        if (DQK == 96 && rope != nullptr) {
            const f32x2* cs = rope + (size_t)(32 * w + li) * 48 + 8 * h;
            bf16x8 a = qf[NKK - 2], b = qf[NKK - 1];
#pragma unroll
            for (int j = 0; j < 8; ++j) {
                const float x1 = bf2f((bf16_t)a[j]), x2 = bf2f((bf16_t)b[j]);
                const f32x2 c = cs[j];
                a[j] = (short)f2bf(x1 * c[0] - x2 * c[1]);
                b[j] = (short)f2bf(x2 * c[0] + x1 * c[1]);
            }
            qf[NKK - 2] = a; qf[NKK - 1] = b;
        }
    }
    f32x16 ot[2];
#pragma unroll
    for (int i = 0; i < 16; ++i) { ot[0][i] = 0.f; ot[1][i] = 0.f; }
    float m_run = -INFINITY, l_run = 0.f;
    const int kkey = tid >> 3, kch = tid & 7;
    const int vkey = lane, vch = w;
    const int rkey = tid >> 2, rch = tid & 3;
    u32x4 kreg, vreg, rreg;
    const unsigned voffK = (unsigned)(kkey * kv_ld + 8 * kch) * 2u, voffV = (unsigned)(vkey * kv_ld + 8 * vch) * 2u, voffR = (unsigned)(rkey * 32 + 8 * rch) * 2u;
#define ATT_LOAD(j) do { const int s0 = (j) * 64; \
        const char* kb_ = (const char*)(s0 < CTXL ? kc + (size_t)s0 * kv_ld : kl + (size_t)(s0 - CTXL) * kv_ld); \
        const char* vb_ = (const char*)(s0 < CTXL ? vc + (size_t)s0 * kv_ld : vl + (size_t)(s0 - CTXL) * kv_ld); \
        kreg = *(const u32x4*)(kb_ + voffK); \
        vreg = *(const u32x4*)(vb_ + voffV); \
        if (DQK == 96 && tid < 256) { const char* rb = (const char*)(s0 < CTXL ? krc + (size_t)s0 * 32 : krl + (size_t)(s0 - CTXL) * 32); rreg = *(const u32x4*)(rb + voffR); } } while (0)
#define ATT_STORE(bufi) do { LAS unsigned char* kb_ = lds + (bufi) * BUF; LAS bf16_t* vt_ = (LAS bf16_t*)(kb_ + KBYTES); \
        *(LAS u32x4*)(kb_ + (kkey * KS + 8 * kch) * 2) = kreg; \
        if (DQK == 96 && tid < 256) *(LAS u32x4*)(kb_ + (rkey * KS + 64 + 8 * rch) * 2) = rreg; \
        _Pragma("unroll") for (int e = 0; e < 4; ++e) { const unsigned wd = vreg[e]; vt_[(8 * vch + 2 * e) * VS + vkey] = (bf16_t)(wd & 0xffffu); vt_[(8 * vch + 2 * e + 1) * VS + vkey] = (bf16_t)(wd >> 16); } } while (0)
    ATT_LOAD(0);
    ATT_STORE(0);
    __syncthreads();
    bf16x8 vf[2][2][2];
    f32x16 st[2];
#define ATT_X(j) do { \
        const LAS unsigned char* kb = lds + ((j) & 1) * BUF; const LAS unsigned char* vt = kb + KBYTES; \
        bf16x8 kf[2][NKK]; \
        _Pragma("unroll") for (int kt = 0; kt < 2; ++kt) _Pragma("unroll") for (int kk = 0; kk < NKK; ++kk) kf[kt][kk] = *(const LAS bf16x8*)(kb + ((32 * kt + li) * KS + 16 * kk + 8 * h) * 2); \
        _Pragma("unroll") for (int vtile = 0; vtile < 2; ++vtile) _Pragma("unroll") for (int kt = 0; kt < 2; ++kt) _Pragma("unroll") for (int s = 0; s < 2; ++s) { \
            const LAS unsigned char* ap = vt + ((32 * vtile + li) * VS + 32 * kt + 16 * s + 4 * h) * 2; \
            const u32x2 lo = *(const LAS u32x2*)ap, hi = *(const LAS u32x2*)(ap + 16); \
            u32x4 vv; vv.x = lo.x; vv.y = lo.y; vv.z = hi.x; vv.w = hi.y; vf[vtile][kt][s] = __builtin_bit_cast(bf16x8, vv); } \
        _Pragma("unroll") for (int kt = 0; kt < 2; ++kt) { \
            _Pragma("unroll") for (int i = 0; i < 16; ++i) st[kt][i] = 0.f; \
            _Pragma("unroll") for (int kk = 0; kk < NKK; ++kk) st[kt] = MFMA32(kf[kt][kk], qf[kk], st[kt]); } } while (0)
#define ATT_Y() do { \
        float mx = fmaxf(fmaxf(st[0][0], st[0][1]), st[0][2]); \
        _Pragma("unroll") for (int i = 3; i < 15; i += 2) mx = fmaxf(fmaxf(mx, st[0][i]), st[0][i + 1]); \
        mx = fmaxf(mx, st[0][15]); \
        _Pragma("unroll") for (int i = 0; i < 16; i += 2) mx = fmaxf(fmaxf(mx, st[1][i]), st[1][i + 1]); \
        mx = fmaxf(mx, __shfl_xor(mx, 32)); \
        if (__any(mx > m_run + 8.f)) { \
            const float m_new = fmaxf(m_run, mx); const float alpha = fast_exp2(m_run - m_new); m_run = m_new; l_run *= alpha; \
            _Pragma("unroll") for (int i = 0; i < 16; ++i) { ot[0][i] *= alpha; ot[1][i] *= alpha; } } \
        { const f32x2 m2 = {m_run, m_run}; f32x2 rs2 = {0.f, 0.f}; \
          _Pragma("unroll") for (int kt = 0; kt < 2; ++kt) _Pragma("unroll") for (int i = 0; i < 16; i += 2) { \
              f32x2 d = (f32x2){st[kt][i], st[kt][i + 1]} - m2; d[0] = fast_exp2(d[0]); d[1] = fast_exp2(d[1]); rs2 += d; st[kt][i] = d[0]; st[kt][i + 1] = d[1]; } \
          l_run += rs2[0] + rs2[1]; } \
        _Pragma("unroll") for (int kt = 0; kt < 2; ++kt) _Pragma("unroll") for (int s = 0; s < 2; ++s) { \
            u32x4 pk; pk.x = pack2(st[kt][8 * s + 0], st[kt][8 * s + 1]); pk.y = pack2(st[kt][8 * s + 2], st[kt][8 * s + 3]); \
            pk.z = pack2(st[kt][8 * s + 4], st[kt][8 * s + 5]); pk.w = pack2(st[kt][8 * s + 6], st[kt][8 * s + 7]); \
            const bf16x8 pf = __builtin_bit_cast(bf16x8, pk); \
            ot[0] = MFMA32(vf[0][kt][s], pf, ot[0]); ot[1] = MFMA32(vf[1][kt][s], pf, ot[1]); } } while (0)
    if (w < 4) {
        for (int j = 0; j < ntiles; ++j) {
            if (j + 1 < ntiles) ATT_LOAD(j + 1);
            ATT_X(j);
            __builtin_amdgcn_s_barrier();
            ATT_Y();
            if (j + 1 < ntiles) ATT_STORE((j + 1) & 1);
            asm volatile("s_waitcnt lgkmcnt(0)" ::: "memory");
            __builtin_amdgcn_s_barrier();
        }
        __builtin_amdgcn_s_barrier();
    } else {
        if (1 < ntiles) ATT_LOAD(1);
        __builtin_amdgcn_s_barrier();
        for (int j = 0; j < ntiles; ++j) {
            ATT_X(j);
            if (j + 1 < ntiles) ATT_STORE((j + 1) & 1);
            asm volatile("s_waitcnt lgkmcnt(0)" ::: "memory");
            __builtin_amdgcn_s_barrier();
            if (j + 2 < ntiles) ATT_LOAD(j + 2);
            ATT_Y();
            __builtin_amdgcn_s_barrier();
        }
    }
#undef ATT_X
#undef ATT_Y
#undef ATT_LOAD
#undef ATT_STORE
    const float lt = l_run + __shfl_xor(l_run, 32);
    const float inv = 1.f / lt;
    bf16_t* orow = obase + (size_t)(32 * w + li) * 1024;
#pragma unroll
    for (int vtile = 0; vtile < 2; ++vtile)
#pragma unroll
        for (int g4 = 0; g4 < 4; ++g4) {
            u32x2 o; o.x = pack2(ot[vtile][4 * g4 + 0] * inv, ot[vtile][4 * g4 + 1] * inv); o.y = pack2(ot[vtile][4 * g4 + 2] * inv, ot[vtile][4 * g4 + 3] * inv);
            *(u32x2*)(orow + 32 * vtile + 8 * g4 + 4 * h) = o;
        }
}

#ifndef HYPROBE
#define HYPROBE 0
#endif
template <int NBLK>
DI void hyena_item(LAS unsigned char* lds, const bf16_t* kf, float inv_norm, float dskip, const bf16_t* hyu, const bf16_t* hyx, bf16_t* mix, int tok0) {
    constexpr int n = 64 * NBLK, CL = 2 * n + 32, NCT = NBLK >= 64 ? 2 : 1;
    const int tid = otid(), lane = tid & 63, w = tid >> 6, li = lane & 31, h = lane >> 5;
    LAS bf16_t* cp = (LAS bf16_t*)lds;
    LAS bf16_t* U = cp + 4 * CL;
    for (int ch = tid; ch < (2 * n) / 8; ch += NTHR) {
        const u32x4 raw = *(const u32x4*)(kf + 8 * ch);
#pragma unroll
        for (int e = 0; e < 8; ++e) {
            const bf16_t v = (e & 1) ? (bf16_t)(raw[e >> 1] >> 16) : (bf16_t)(raw[e >> 1] & 0xffffu);
            const int x = 8 * ch + e;
#pragma unroll
            for (int r = 0; r < 4; ++r) cp[r * CL + 2 * n + 3 - r - x] = v;
        }
    }
    if (tid < 144) {
        const int r = tid / 36, k = tid % 36, idx = k < 4 ? k : 2 * n + (k - 4);
        if (idx < 4 - r || idx > 2 * n + 3 - r) cp[r * CL + idx] = (bf16_t)0;
    }
    {
        const bf16_t* hb = hyu + tok0;
        for (int i8 = tid; i8 < n; i8 += NTHR) {
            const int idx = 8 * i8, b = idx / n, s = idx % n;
            *(LAS u32x4*)(U + (b * NBLK + (s >> 6)) * 72 + (s & 63)) = *(const u32x4*)(hb + idx);
        }
    }
    __syncthreads();
    unsigned long long hyt0_ = 0; if (HYPROBE == 1) hyt0_ = __builtin_amdgcn_s_memrealtime();
    f32x16 acc[2][NCT];
#pragma unroll
    for (int mt = 0; mt < 2; ++mt)
#pragma unroll
        for (int ct = 0; ct < NCT; ++ct)
#pragma unroll
            for (int i = 0; i < 16; ++i) acc[mt][ct][i] = 0.f;
    const LAS bf16_t* Uw = U + (size_t)w * NBLK * 72;
#pragma unroll 1
    for (int d = -(NBLK - 1); d <= NBLK - 1; ++d) {
        bool act[NCT]; int blk[NCT]; bool val[NCT];
#pragma unroll
        for (int ct = 0; ct < NCT; ++ct) {
            act[ct] = (32 * ct + 31 - d >= 0) && (32 * ct - d <= NBLK - 1);
            const int a = 32 * ct + li; blk[ct] = a - d; val[ct] = (blk[ct] >= 0) && (blk[ct] < NBLK) && (a < NBLK);
        }
#pragma unroll
        for (int ks = 0; ks < 4; ++ks) {
            bf16x8 af[2];
#pragma unroll
            for (int mt = 0; mt < 2; ++mt) {
                const int y0 = n - 1 - 64 * d - (32 * mt + li) + 16 * ks + 8 * h;
                const int r = y0 & 3, m0 = y0 - r + 4;
                const LAS bf16_t* ap = cp + r * CL + m0;
                const u32x2 lo = *(const LAS u32x2*)ap, hi = *(const LAS u32x2*)(ap + 4);
                u32x4 vv; vv.x = lo.x; vv.y = lo.y; vv.z = hi.x; vv.w = hi.y;
                af[mt] = __builtin_bit_cast(bf16x8, vv);
            }
#pragma unroll
            for (int ct = 0; ct < NCT; ++ct) {
                if (act[ct]) {
                    u32x4 bv = {0u, 0u, 0u, 0u};
                    if (val[ct]) bv = *(const LAS u32x4*)(Uw + blk[ct] * 72 + 16 * ks + 8 * h);
                    const bf16x8 bfv = __builtin_bit_cast(bf16x8, bv);
                    acc[0][ct] = MFMA32(af[0], bfv, acc[0][ct]);
                    acc[1][ct] = MFMA32(af[1], bfv, acc[1][ct]);
                }
            }
        }
    }
    if (HYPROBE == 1 && NBLK == 64) { __syncthreads(); if (threadIdx.x == 0) *(LAS unsigned long long*)(lds + LDS_BYTES - 32) += __builtin_amdgcn_s_memrealtime() - hyt0_; }
#pragma unroll
    for (int mt = 0; mt < 2; ++mt)
#pragma unroll
        for (int ct = 0; ct < NCT; ++ct) {
            const int a = 32 * ct + li;
            if (a < NBLK) {
                unsigned tokb = (unsigned)(tok0 + w * n + 64 * a + 32 * mt + 4 * h);
                asm volatile("" : "+v"(tokb));
                const LAS bf16_t* up = Uw + a * 72 + 32 * mt + 4 * h;
                u32x2 xvv[4];
#pragma unroll
                for (int g = 0; g < 4; ++g) xvv[g] = *(const u32x2*)(hyx + tokb + 8u * g);
#pragma unroll
                for (int g = 0; g < 4; ++g) {
                    const unsigned tok = tokb + 8u * g;
                    const u32x2 xv = xvv[g];
                    const u32x2 uv = *(const LAS u32x2*)(up + 8 * g);
                    float o[4];
#pragma unroll
                    for (int j = 0; j < 4; ++j) {
                        const unsigned xw = j < 2 ? xv.x : xv.y, uw = j < 2 ? uv.x : uv.y;
                        const float x0 = (j & 1) ? __uint_as_float(xw & 0xffff0000u) : __uint_as_float(xw << 16);
                        const float uu = (j & 1) ? __uint_as_float(uw & 0xffff0000u) : __uint_as_float(uw << 16);
                        o[j] = (acc[mt][ct][4 * g + j] * inv_norm + uu * dskip) * x0;
                    }
                    u32x2 ov; ov.x = pack2(o[0], o[1]); ov.y = pack2(o[2], o[3]);
                    *(u32x2*)(mix + tok) = ov;
                }
            }
            __builtin_amdgcn_sched_barrier(0);
        }
}

DI void phase_mix(const Params& p, int l, bool need_ctx, LAS unsigned char* lds) {
    const bf16_t* PA = (const bf16_t*)(WSP() + OFF_PA);
    const bf16_t* UPB = (const bf16_t*)(WSP() + OFF_UPB);
    const bf16_t* KR = (const bf16_t*)(WSP() + OFF_KR);
    const bf16_t* HYU = (const bf16_t*)(WSP() + OFF_HYU);
    const bf16_t* HYX = (const bf16_t*)(WSP() + OFF_HYX);
    bf16_t* MIX = (bf16_t*)(WSP() + OFF_R1);
    const f32x2* ROPE = (const f32x2*)(WSP() + OFF_ROPE);
    const int n_items = 256 + 768 + 768 + (need_ctx ? 48 + 48 + 256 : 0);
    LAS float* red = (LAS float*)lds;
    for (int it = obid(); it < n_items; it += gridDim.x) {
        int lin = 0;
        if (it >= 256 && it < 1792) { const int j = it - 256, r = j >> 8, bp = j & 255; lin = ((r * 8 + (bp & 7)) << 5) + (bp >> 3); }
#ifndef MIXSEL
#define MIXSEL 0
#endif
        if ((MIXSEL == 0 || MIXSEL == 1) && (it < 256 || it >= 1888)) {
            const bool isl = it < 256;
            const int c = isl ? it : it - 1888;
            const float* part = isl ? (const float*)(WSP() + OFF_PART) + (size_t)l * 128 * 512 : (const float*)(WSP() + OFF_PARTC) + (size_t)l * 8 * 512;
            const int np = isl ? 128 : 8;
            float s = 0.f;
            const int tq_ = otid();
            if (tq_ < 2 * np) { const int r = tq_ >> 1, hb = tq_ & 1; s = part[(size_t)r * 512 + hb * 256 + c]; }
            s = wave_sum(s);
            __syncthreads();
            if ((tq_ & 63) == 0) red[tq_ >> 6] = s;
            __syncthreads();
            float nrm = 0.f;
#pragma unroll
            for (int i = 0; i < 8; ++i) nrm += red[i];
            __syncthreads();
            const float inv_norm = 1.f / nrm, dskip = INP(26)[l * 256 + c];
            bf16_t* OBT = (bf16_t*)(WSP() + OFF_OBT);
            if (isl) hyena_item<64>(lds, (const bf16_t*)(WSP() + OFF_KF) + ((size_t)l * 256 + c) * 8192, inv_norm, dskip, HYU + (size_t)c * MTOT, HYX + (size_t)c * MTOT, OBT + (size_t)c * MTOT, 0);
            else hyena_item<4>(lds, (const bf16_t*)(WSP() + OFF_KFC) + ((size_t)l * 256 + c) * 512, inv_norm, dskip, HYU + (size_t)c * MTOT, HYX + (size_t)c * MTOT, OBT + (size_t)c * MTOT, MLAT);
        } else if ((MIXSEL == 0 || MIXSEL == 2) && it < 1792 && lin < 768) {
            const int idx = lin, qb = idx & 15, hd = (idx >> 4) % 6, b = idx / 96, hk = hd / 3;
            const size_t tl = (size_t)b * SEQ, tc = (size_t)MLAT + (size_t)b * CTXL;
            attn_item<64>(lds, PA + (tl + qb * 256) * 640 + hd * 64, 640, PA + tc * 640 + 384 + hk * 64, PA + tl * 640 + 384 + hk * 64,
                          PA + tc * 640 + 512 + hk * 64, PA + tl * 640 + 512 + hk * 64, 640, nullptr, nullptr, 68, MIX + (tl + qb * 256) * 1024 + hd * 64, nullptr);
        } else if ((MIXSEL == 0 || MIXSEL == 3) && it < 1792) {
            const int idx = lin - 768, qb = idx & 15, hd = (idx >> 4) % 6, b = idx / 96;
            const size_t tl = (size_t)b * SEQ, tc = (size_t)MLAT + (size_t)b * CTXL;
            attn_item<96>(lds, UPB + (tl + qb * 256) * 1344 + hd * 96, 1344, UPB + tc * 1344 + 576 + hd * 128, UPB + tl * 1344 + 576 + hd * 128,
                          UPB + tc * 1344 + 576 + hd * 128 + 64, UPB + tl * 1344 + 576 + hd * 128 + 64, 1344, KR + tc * 32, KR + tl * 32, 68,
                          MIX + (tl + qb * 256) * 1024 + 640 + hd * 64, ROPE + (size_t)(qb * 256) * 48 + 32);
        } else if ((MIXSEL == 0 || MIXSEL == 2) && it < 1840) {
            const int idx = it - 1792, hd = idx % 6, b = idx / 6, hk = hd / 3;
            const size_t tc = (size_t)MLAT + (size_t)b * CTXL;
            attn_item<64>(lds, PA + tc * 640 + hd * 64, 640, PA + tc * 640 + 384 + hk * 64, PA + tc * 640 + 384 + hk * 64,
                          PA + tc * 640 + 512 + hk * 64, PA + tc * 640 + 512 + hk * 64, 640, nullptr, nullptr, 4, MIX + tc * 1024 + hd * 64, nullptr);
        } else if (MIXSEL == 0 || MIXSEL == 3) {
            const int idx = it - 1840, hd = idx % 6, b = idx / 6;
            const size_t tc = (size_t)MLAT + (size_t)b * CTXL;
            attn_item<96>(lds, UPB + tc * 1344 + hd * 96, 1344, UPB + tc * 1344 + 576 + hd * 128, UPB + tc * 1344 + 576 + hd * 128,
                          UPB + tc * 1344 + 576 + hd * 128 + 64, UPB + tc * 1344 + 576 + hd * 128 + 64, 1344, KR + tc * 32, KR + tc * 32, 4,
                          MIX + tc * 1024 + 640 + hd * 64, nullptr);
        }
        __syncthreads();
    }
}

DI void phase_untranspose(const Params& p, bool need_ctx, LAS unsigned char* lds) {
    const int tid = otid();
    const bf16_t* OBT = (const bf16_t*)(WSP() + OFF_OBT);
    bf16_t* MIX = (bf16_t*)(WSP() + OFF_R1);
    LAS bf16_t* T = (LAS bf16_t*)lds;
    const int ntile = (need_ctx ? MTOT : MLAT) / 64;
    for (int tile = obid(); tile < ntile; tile += gridDim.x) {
        {
            const int ch = tid >> 1, half = tid & 1;
            const bf16_t* src = OBT + (size_t)ch * MTOT + tile * 64 + 32 * half;
#pragma unroll
            for (int q = 0; q < 4; ++q) *(LAS u32x4*)(T + ch * 72 + 32 * half + 8 * q) = *(const u32x4*)(src + 8 * q);
        }
        __syncthreads();
        {
            const int tk = tid >> 3, cg = (tid & 7) * 32;
            unsigned w[16];
#pragma unroll
            for (int j = 0; j < 16; ++j) w[j] = (unsigned)T[(cg + 2 * j) * 72 + tk] | ((unsigned)T[(cg + 2 * j + 1) * 72 + tk] << 16);
            bf16_t* dst = MIX + (size_t)(tile * 64 + tk) * 1024 + 384 + cg;
#pragma unroll
            for (int q = 0; q < 4; ++q) { u32x4 o; o.x = w[4 * q]; o.y = w[4 * q + 1]; o.z = w[4 * q + 2]; o.w = w[4 * q + 3]; *(u32x4*)(dst + 8 * q) = o; }
        }
        __syncthreads();
    }
}

#define XB_TMO      128
#define XB_XCNT(j)  (256  + 64 * (j))
#define XB_XSUB(j)  (1280 + 64 * (j))
#define XB_XGEN(j)  (2304 + 64 * (j))
#define XB_TOP      3328
#define XB_TOPGEN   3392
#define XCD_BAR_WORDS 3456
#define XB_SPIN_CAP (1u << 22)
DI unsigned xb_ld(unsigned* p)              { return __hip_atomic_load(p, __ATOMIC_RELAXED, __HIP_MEMORY_SCOPE_AGENT); }
DI unsigned xb_add(unsigned* p, unsigned v) { return __hip_atomic_fetch_add(p, v, __ATOMIC_RELAXED, __HIP_MEMORY_SCOPE_AGENT); }
DI unsigned xb_xcc_id() { return (unsigned)__builtin_amdgcn_s_getreg((3 << 11) | 20) & 0xFu; }
#define XB_SPIN(cond, bar) do { unsigned _sp = 0; while (cond) { __builtin_amdgcn_s_sleep(1); \
    if ((++_sp & 255u) == 0u) { if (xb_ld(&(bar)[XB_TMO])) break; if (_sp > XB_SPIN_CAP) { atomicAdd(&(bar)[XB_TMO], 1u); break; } } } } while (0)
struct XcdBarrier { unsigned* bar; unsigned x; volatile LAS unsigned* st; };
DI XcdBarrier xcd_barrier_post(unsigned* bar, volatile LAS unsigned* st) {
    XcdBarrier b; b.bar = bar; b.x = xb_xcc_id(); b.st = st;
    if (threadIdx.x == 0) (void)xb_add(&bar[XB_XCNT(b.x)], 1u);
    return b;
}
DI void xcd_barrier_complete(unsigned* bar, unsigned x, unsigned& nloc, unsigned& nx) {
    const unsigned G = gridDim.x * gridDim.y * gridDim.z;
    unsigned sum, cnt, mine, sp = 0u;
    for (;;) {
        sum = 0u; cnt = 0u; mine = 0u;
#pragma unroll
        for (unsigned j = 0; j < 16; ++j) { const unsigned c = xb_ld(&bar[XB_XCNT(j)]); sum += c; cnt += (c > 0u) ? 1u : 0u; mine = (j == x) ? c : mine; }
        if (sum == G) break;
        __builtin_amdgcn_s_sleep(1);
        if ((++sp & 255u) == 0u) { if (xb_ld(&bar[XB_TMO])) break; if (sp > XB_SPIN_CAP) { atomicAdd(&bar[XB_TMO], 1u); break; } }
    }
    nloc = mine > 0u ? mine : 1u; nx = cnt > 0u ? cnt : 1u;
}
DI void xcd_barrier(const XcdBarrier& b) {
    asm volatile("s_waitcnt vmcnt(0)" ::: "memory");
    __syncthreads();
    if (threadIdx.x == 0) {
        unsigned* bar = b.bar;
        __builtin_amdgcn_s_waitcnt(0);
        unsigned nloc = b.st[0], nx = b.st[1];
        if (nloc == 0u) { xcd_barrier_complete(bar, b.x, nloc, nx); b.st[0] = nloc; b.st[1] = nx; }
        const unsigned old = xb_add(&bar[XB_XSUB(b.x)], 1u);
        const unsigned gen = old / nloc;
        if (old + 1u == (gen + 1u) * nloc) {
            __builtin_amdgcn_fence(__ATOMIC_RELEASE, "agent");
            asm volatile("s_waitcnt vmcnt(0)" ::: "memory");
            const unsigned og = xb_add(&bar[XB_TOP], 1u);
            const unsigned tg = og / nx;
            if (og + 1u == (tg + 1u) * nx) xb_add(&bar[XB_TOPGEN], 1u);
            else XB_SPIN(xb_ld(&bar[XB_TOPGEN]) == tg, bar);
            __builtin_amdgcn_fence(__ATOMIC_ACQUIRE, "agent");
            xb_add(&bar[XB_XGEN(b.x)], 1u);
            asm volatile("s_waitcnt vmcnt(0)" ::: "memory");
        } else {
            XB_SPIN(xb_ld(&bar[XB_XGEN(b.x)]) == gen, bar);
            __builtin_amdgcn_fence(__ATOMIC_ACQUIRE, "agent");
            asm volatile("s_waitcnt vmcnt(0)" ::: "memory");
        }
    }
    __syncthreads();
}

__global__ void __launch_bounds__(NTHR) mega(Params p) {
    extern __shared__ __attribute__((aligned(16))) unsigned char lds_raw[];
    LAS unsigned char* lds = (LAS unsigned char*)lds_raw;
    cg::grid_group grid = cg::this_grid();
    int ph = 0;
#ifndef ONLY
#define ONLY -1
#endif
#ifndef TPROBE
#define TPROBE -1
#endif
#define PHASE(kind, body) do { if ((ONLY < 0 || ONLY == (kind)) && ph >= p.ph_lo && ph < p.ph_hi) { \
        unsigned long long t0_ = 0; if (TPROBE == (kind)) t0_ = __builtin_amdgcn_s_memrealtime(); \
        { unsigned char* ws = WSP(); body; } \
        if (ph + 1 < p.ph_hi) { if (ph == 0) grid.sync(); else xcd_barrier(xbar); } \
        if (TPROBE == (kind)) tprobe += __builtin_amdgcn_s_memrealtime() - t0_; } ++ph; } while (0)
    unsigned long long tprobe = 0;
    {
        volatile LAS unsigned* st = (volatile LAS unsigned*)(lds + LDS_BYTES - 16);
        if (threadIdx.x == 0) { st[0] = 0u; st[1] = 0u; *(LAS unsigned long long*)(lds + LDS_BYTES - 32) = 0ull; }
        __syncthreads();
    }
    XcdBarrier xbar = xcd_barrier_post((unsigned*)(WSP() + OFF_BAR), (volatile LAS unsigned*)(lds + LDS_BYTES - 16));
#ifndef DUP_P0
#define DUP_P0 1
#endif
#pragma unroll 1
    for (int rep = 0; rep < DUP_P0; ++rep) {
    PHASE(0, phase_p0a(p, lds));
    PHASE(1, phase_ln(p, MTOT, true, nullptr, nullptr, true, 0, 0, 1, false));
    }
#ifndef XSYNC
#define XSYNC 0
#endif
#pragma unroll 1
    for (int rep = 0; rep < XSYNC; ++rep) grid.sync();
#pragma unroll 1
    for (int l = 0; l < 2; ++l) {
#pragma unroll 1
        for (int s = 0; s < 3; ++s) {
#define X ((float*)(ws + OFF_X))
#define H ((bf16_t*)(ws + OFF_R1))
#define ACT ((bf16_t*)(ws + OFF_R2))
#define W (ws + OFF_W + (size_t)l * SZ_WL)
#define mod ((const float*)(ws + OFF_MOD) + (size_t)l * 9 * 9216)
            const int Mrows = (l == 1 && s == 2) ? MLAT : MTOT;
            if (s != 1) {
#define wgu ((const bf16_t*)(W + (s == 0 ? WO_GU1 : WO_GU2)))
#define wd ((const bf16_t*)(W + (s == 0 ? WO_D1 : WO_D2)))
#ifndef DUP_GU
#define DUP_GU 1
#endif
#ifndef DUP_MIX
#define DUP_MIX 1
#endif
#pragma unroll 1
                for (int rep = 0; rep < DUP_GU; ++rep)
                PHASE(2, gm::gemm_phase(lds, H, 1024, wgu, 1024, Mrows, 5632, 1024, gm::EpiSwiglu{ACT}));
                const bool last = (l == 1 && s == 2);
                const bool dm = !last;
                const int lm = (s == 0) ? l : l + 1;
                const float* lg = INP(10) + (size_t)(l * 3 + s) * D; const float* lb = INP(11) + (size_t)(l * 3 + s) * D;
#define YD ((bf16_t*)(ws + OFF_R1))
#define er (gm::EpiResid{YD, mod + (s == 0 ? 2 : 8) * 1024, 0.5f})
                PHASE(3, gm::gemm_phase(lds, ACT, DFF, wd, DFF, MLAT, 1024, DFF, er));
                if (Mrows == MTOT) {
                    PHASE(9, { if (obid() < 32) gm::gemm_phase(lds, ACT, DFF, wd, DFF, MCTX, 1024, DFF, er, MLAT / 256, 0, 32);
                               else phase_ln(p, MLAT, false, lg, lb, dm, dm ? lm : 0, s == 0 ? 3 : 0, s == 0 ? 4 : 1, last, 0, 32, (int)gridDim.x - 32, YD, l == 0 && s == 0); });
                    PHASE(1, phase_ln(p, MTOT, false, lg, lb, dm, dm ? lm : 0, s == 0 ? 3 : 0, s == 0 ? 4 : 1, last, MLAT, 0, 0, YD, l == 0 && s == 0));
                } else {
                    PHASE(1, phase_ln(p, MLAT, false, lg, lb, dm, dm ? lm : 0, s == 0 ? 3 : 0, s == 0 ? 4 : 1, last, 0, 0, 0, YD, l == 0 && s == 0));
                }
            } else {
#ifndef DUP_WP
#define DUP_WP 1
#endif
#pragma unroll 1
                for (int rep = 0; rep < DUP_WP; ++rep) {
                PHASE(4, gm::gemm_phase(lds, H, 1024, (const bf16_t*)(W + WO_IN), 1024, MTOT, 2048, 1024,
                                     gm::EpiWin{(bf16_t*)(ws + OFF_PA), (bf16_t*)(ws + OFF_PBB), (bf16_t*)(ws + OFF_PC)}));
                PHASE(5, phase_post(p, l, lds));
                }
                PHASE(6, gm::gemm_phase(lds, (const bf16_t*)(ws + OFF_R1), 384, (const bf16_t*)(W + WO_UP), 384, MTOT, 1536, 384,
                                     gm::EpiUp{(bf16_t*)(ws + OFF_UPB), 0.10206207261596577f * LOG2E}));
#pragma unroll 1
                for (int rep = 0; rep < DUP_MIX; ++rep)
{                 PHASE(7, phase_mix(p, l, l == 0, lds)); }
                PHASE(10, phase_untranspose(p, l == 0, lds));
                const float* lg = INP(10) + (size_t)(l * 3 + 1) * D; const float* lb = INP(11) + (size_t)(l * 3 + 1) * D;
#undef er
#undef YD
#define YD ((bf16_t*)(ws + OFF_R2))
#define er (gm::EpiResid{YD, mod + 5 * 1024, 1.0f})
#define MIXp ((const bf16_t*)(ws + OFF_R1))
#define wo ((const bf16_t*)(W + WO_OUT))
                PHASE(8, gm::gemm_phase(lds, MIXp, 1024, wo, 1024, MLAT, 1024, 1024, er));
                if (l == 0) {
                    PHASE(9, { if (obid() < 32) gm::gemm_phase(lds, MIXp, 1024, wo, 1024, MCTX, 1024, 1024, er, MLAT / 256, 0, 32);
                               else phase_ln(p, MLAT, false, lg, lb, true, l, 6, 7, false, 0, 32, (int)gridDim.x - 32, YD); });
                    PHASE(1, phase_ln(p, MTOT, false, lg, lb, true, l, 6, 7, false, MLAT, 0, 0, YD));
                } else {
                    PHASE(1, phase_ln(p, MLAT, false, lg, lb, true, l, 6, 7, false, 0, 0, 0, YD));
                }
            }
        }
    }
    if (HYPROBE || PPROBE) tprobe = *(LAS unsigned long long*)(lds + LDS_BYTES - 32);
    if (TPROBE >= 0 || HYPROBE || PPROBE) {
        xcd_barrier(xbar);
        if (obid() == 0) {
            const unsigned m = (unsigned)(tprobe / 10ull);
            for (unsigned i = threadIdx.x; i < m && i < 200000u; i += NTHR) OUTP()[(size_t)i * 131u] += 0.1f;
        }
    }
}

constexpr int NPHASES = 1 << 20;

extern "C" void kernel_launch(void* const* d_in, const int* in_sizes, int n_in, void* d_out, int out_size, void* d_ws, size_t ws_size, hipStream_t stream) {
    static int grid = 0;
    if (grid == 0) {
        if (n_in != 31 || ws_size < WS_END) { fprintf(stderr, "kernel_launch: unexpected n_in %d or ws_size %zu (< %zu)\n", n_in, ws_size, (size_t)WS_END); grid = -1; return; }
        int dev = 0, cus = 0, per_cu = 0;
        hipGetDevice(&dev);
        hipDeviceGetAttribute(&cus, hipDeviceAttributeMultiprocessorCount, dev);
        if (hipFuncSetAttribute((const void*)mega, hipFuncAttributeMaxDynamicSharedMemorySize, LDS_BYTES) != hipSuccess) { fprintf(stderr, "kernel_launch: hipFuncSetAttribute failed\n"); grid = -1; return; }
        if (hipOccupancyMaxActiveBlocksPerMultiprocessor(&per_cu, (const void*)mega, NTHR, LDS_BYTES) != hipSuccess || per_cu < 1) { fprintf(stderr, "kernel_launch: occupancy query failed (%d)\n", per_cu); per_cu = 1; }
        (void)hipGetLastError();
        grid = cus * (per_cu > 1 ? 1 : per_cu);
    }
    if (grid < 0) return;
    Params prm{};
    for (int i = 0; i < 31; ++i) prm.in[i] = (const float*)d_in[i];
    prm.out = (float*)d_out; prm.ws = (unsigned char*)d_ws;
    prm.ph_lo = 0; prm.ph_hi = NPHASES;
    (void)hipMemsetAsync((unsigned char*)d_ws + OFF_BAR, 0, 4096 * 4, stream);
    void* args[] = {&prm};
    hipError_t e = hipLaunchCooperativeKernel((const void*)mega, dim3(grid), dim3(NTHR), args, LDS_BYTES, stream);
    if (e != hipSuccess) fprintf(stderr, "kernel_launch: cooperative launch failed: %s (grid %d)\n", hipGetErrorString(e), grid);
}
```

```cpp
#include <hip/hip_runtime.h>
#include <hip/hip_cooperative_groups.h>
#include <cstdio>
#include <cstdint>
namespace cg = cooperative_groups;

#define LAS __attribute__((address_space(3)))
#define DI __device__ __forceinline__
typedef unsigned short bf16_t;
typedef short bf16x8 __attribute__((ext_vector_type(8)));
typedef short s16x4 __attribute__((ext_vector_type(4)));
typedef float f32x2 __attribute__((ext_vector_type(2)));
typedef float f32x4 __attribute__((ext_vector_type(4)));
typedef float f32x16 __attribute__((ext_vector_type(16)));
typedef unsigned u32x2 __attribute__((ext_vector_type(2)));
typedef unsigned u32x4 __attribute__((ext_vector_type(4)));
typedef __bf16 bf2_t __attribute__((ext_vector_type(2)));

constexpr int D = 1024, NB = 8, SEQ = 4096, CTXL = 256, DFF = 2816;
constexpr int MLAT = NB * SEQ, MCTX = NB * CTXL, MTOT = MLAT + MCTX;
constexpr float EPS = 1e-6f, ALPHA = 1.41421356237309515f, LOG2E = 1.44269504088896341f;
constexpr int NTHR = 512;
constexpr int LDS_BYTES = 147456;

constexpr size_t SZ_X = (size_t)MTOT * D * 4;
constexpr size_t WO_GU1 = 0, WO_D1 = WO_GU1 + (size_t)5632 * 1024 * 2, WO_GU2 = WO_D1 + (size_t)1024 * 2816 * 2, WO_D2 = WO_GU2 + (size_t)5632 * 1024 * 2,
                 WO_IN = WO_D2 + (size_t)1024 * 2816 * 2, WO_OUT = WO_IN + (size_t)2048 * 1024 * 2, WO_UP = WO_OUT + (size_t)1024 * 1024 * 2, SZ_WL = WO_UP + (size_t)1536 * 384 * 2;
constexpr size_t OFF_X = 0;
constexpr size_t OFF_W = OFF_X + SZ_X;
constexpr size_t OFF_MOD = OFF_W + 2 * SZ_WL;
constexpr size_t OFF_KF = OFF_MOD + (size_t)2 * 9 * 9216 * 4;
constexpr size_t OFF_KFC = OFF_KF + (size_t)2 * 256 * 8192 * 2;
constexpr size_t OFF_PART = OFF_KFC + (size_t)2 * 256 * 512 * 2;
constexpr size_t OFF_PARTC = OFF_PART + (size_t)2 * 128 * 512 * 4;
constexpr size_t OFF_ROPE = OFF_PARTC + (size_t)2 * 8 * 512 * 4;
constexpr size_t OFF_R1 = OFF_ROPE + (size_t)4096 * 48 * 8;
constexpr size_t SZ_R1 = (size_t)MTOT * 1024 * 2;
constexpr size_t OFF_R2 = OFF_R1 + SZ_R1;
constexpr size_t SZ_R2 = (size_t)MTOT * DFF * 2;
constexpr size_t OFF_PA = OFF_R2;
constexpr size_t OFF_HYU = OFF_PA + (size_t)MTOT * 640 * 2;
constexpr size_t OFF_HYX = OFF_HYU + (size_t)MTOT * 256 * 2;
constexpr size_t OFF_KR = OFF_HYX + (size_t)MTOT * 256 * 2;
constexpr size_t OFF_PBB = OFF_KR + (size_t)MTOT * 32 * 2;
constexpr size_t OFF_PC = OFF_PBB + (size_t)MTOT * 768 * 2;
constexpr size_t OFF_UPB = OFF_PBB;
constexpr size_t OFF_OBT = OFF_UPB + (size_t)MTOT * 1344 * 2;
constexpr size_t OFF_BAR = OFF_R2 + SZ_R2;
constexpr size_t WS_END = OFF_BAR + (size_t)4096 * 4;
static_assert(OFF_PC + (size_t)MTOT * 416 * 2 <= WS_END, "R2 overflow");
static_assert(OFF_OBT + (size_t)MTOT * 256 * 2 <= OFF_R2 + SZ_R2, "R2 overflow");
static_assert(WS_END <= (size_t)536870912, "workspace too large");

struct Params {
    const float* in[31];
    float* out;
    unsigned char* ws;
    int ph_lo, ph_hi;
};


typedef __attribute__((address_space(4))) const unsigned char* kargp_t;
DI kargp_t karg_base() { kargp_t k = (kargp_t)__builtin_amdgcn_kernarg_segment_ptr(); asm volatile("" : "+s"(k)); return k; }
#define GAS __attribute__((address_space(1)))
DI const float* INP(int i) { const float* q = *(const float* __attribute__((address_space(4))) const*)(karg_base() + 8 * i); return q; }
DI float* OUTP() { float* q = *(float* __attribute__((address_space(4))) const*)(karg_base() + 8 * 31); return q; }
DI unsigned char* WSP() { unsigned char* q = *(unsigned char* __attribute__((address_space(4))) const*)(karg_base() + 8 * 32); return q; }

DI float bf2f(bf16_t b) { return __uint_as_float(((unsigned)b) << 16); }
DI unsigned pack2(float a, float b) { f32x2 v = {a, b}; bf2_t r = __builtin_convertvector(v, bf2_t); return __builtin_bit_cast(unsigned, r); }
DI bf16_t f2bf(float a) { return (bf16_t)(pack2(a, 0.f) & 0xffffu); }
DI float wave_sum(float v) {
#pragma unroll
    for (int o = 32; o > 0; o >>= 1) v += __shfl_xor(v, o);
    return v;
}
DI float fast_exp2(float x) { return __builtin_amdgcn_exp2f(x); }
DI int otid() { int t = threadIdx.x; asm volatile("" : "+v"(t)); return t; }
DI int obid() { int t = blockIdx.x; asm volatile("" : "+s"(t)); return t; }
DI int crow(int reg, int h) { return (reg & 3) + 8 * (reg >> 2) + 4 * h; }
#define MFMA32(a, b, c) __builtin_amdgcn_mfma_f32_32x32x16_bf16((a), (b), (c), 0, 0, 0)

DI void conv_item(const Params& p, int it, LAS unsigned char* lds) {
    LAS float* tile = (LAS float*)lds;
    const int tid = otid();
    const int l = it / 2568; int r = it % 2568;
    int mat, K; size_t woff;
    if (r < 704) { mat = 0; K = 1024; woff = WO_GU1; }
    else if (r < 1056) { r -= 704; mat = 1; K = 2816; woff = WO_D1; }
    else if (r < 1760) { r -= 1056; mat = 2; K = 1024; woff = WO_GU2; }
    else if (r < 2112) { r -= 1760; mat = 3; K = 2816; woff = WO_D2; }
    else if (r < 2368) { r -= 2112; mat = 4; K = 1024; woff = WO_IN; }
    else if (r < 2496) { r -= 2368; mat = 5; K = 1024; woff = WO_OUT; }
    else { r -= 2496; mat = 6; K = 384; woff = WO_UP; }
    const int nK = K / 64, tn = r / nK, tk = r % nK, n0 = tn * 128, k0 = tk * 64;
    bf16_t* dst = (bf16_t*)(WSP() + OFF_W + (size_t)l * SZ_WL + woff);
    {
        const int kk = tid >> 7, n = n0 + (tid & 127);
        const float* sp; const float* sc = nullptr; int ld, klo = 0, khi = K; bool zero = false;
        if (mat == 0 || mat == 2) {
            const int tl_ = n >> 8, c_ = n & 255, bj_ = c_ >> 7, wc_ = (c_ >> 5) & 3, t_ = (c_ >> 4) & 1, fq_ = (c_ >> 2) & 3, j_ = c_ & 3;
            const int unit = tl_ * 128 + wc_ * 32 + fq_ * 8 + bj_ * 4 + j_, col = t_ * 2816 + unit;
            sp = (mat == 0 ? INP(6) : INP(8)) + (size_t)l * 1024 * 5632 + col; ld = 5632;
        } else if (mat == 1 || mat == 3) {
            const int an = (n & ~31) + 8 * ((n & 15) >> 2) + 4 * ((n >> 4) & 1) + (n & 3);
            sp = (mat == 1 ? INP(7) : INP(9)) + (size_t)l * 2816 * 1024 + an; ld = 1024;
        } else if (mat == 4) {
            const int an = (n & ~31) + 8 * ((n & 15) >> 2) + 4 * ((n >> 4) & 1) + (n & 3);
            zero = an >= 1824; sp = INP(12) + (size_t)l * 1024 * 1824 + (zero ? 0 : an); ld = 1824;
        } else if (mat == 5) {
            const int an = (n & ~31) + 8 * ((n & 15) >> 2) + 4 * ((n >> 4) & 1) + (n & 3);
            sp = INP(13) + (size_t)l * 1024 * 1024 + an; ld = 1024;
        } else {
            const int an = (n & ~31) + 8 * ((n & 15) >> 2) + 4 * ((n >> 4) & 1) + (n & 3);
            if (an < 576) { sp = INP(29) + (size_t)l * 256 * 576 + an; ld = 576; khi = 256; sc = INP(27) + l * 256; }
            else if (an < 1344) { sp = INP(30) + (size_t)l * 128 * 768 + (an - 576); ld = 768; klo = 256; sc = INP(28) + l * 128; }
            else { zero = true; sp = INP(29); ld = 0; sc = INP(27); }
        }
        const bool has_sc = (mat == 6);
        float v[16];
#pragma unroll
        for (int ps = 0; ps < 16; ++ps) {
            const int k = k0 + ps * 4 + kk;
            const bool valid = !zero && k >= klo && k < khi;
            const int idx = valid ? k - klo : 0;
            float x = sp[(size_t)idx * ld];
            if (has_sc) x *= sc[idx];
            v[ps] = valid ? x : 0.f;
        }
#pragma unroll
        for (int ps = 0; ps < 16; ++ps) tile[(ps * 4 + kk) * 129 + (tid & 127)] = v[ps];
    }
    __syncthreads();
    {
        const int nl = tid >> 2, kc = (tid & 3) * 16;
#pragma unroll
        for (int hh = 0; hh < 2; ++hh) {
            const int kb = kc + hh * 8;
            u32x4 o;
            o.x = pack2(tile[(kb + 0) * 129 + nl], tile[(kb + 1) * 129 + nl]);
            o.y = pack2(tile[(kb + 2) * 129 + nl], tile[(kb + 3) * 129 + nl]);
            o.z = pack2(tile[(kb + 4) * 129 + nl], tile[(kb + 5) * 129 + nl]);
            o.w = pack2(tile[(kb + 6) * 129 + nl], tile[(kb + 7) * 129 + nl]);
            *(u32x4*)(dst + (size_t)(n0 + nl) * K + k0 + kb) = o;
        }
    }
}

DI void mod_item(const Params& p, int it, LAS unsigned char* lds) {
    LAS float* s = (LAS float*)lds;
    LAS float* red = s + 12 * 1024;
    const int tid = otid();
    const int l = it / 144, jb = it % 144, j0 = jb * 64;
    {
        const float* cvec = INP(1); const float* cctx = INP(3);
        float vv[18];
#pragma unroll
        for (int q = 0; q < 18; ++q) { const int idx = tid + q * NTHR, r = idx >> 10, k = idx & 1023; vv[q] = r < 8 ? cvec[r * 1024 + k] : cctx[k]; }
#pragma unroll
        for (int q = 0; q < 18; ++q) { const int idx = tid + q * NTHR, r = idx >> 10, k = idx & 1023; s[k * 12 + r] = vv[q] / (1.f + __expf(-vv[q])); }
    }
    __syncthreads();
    const int jc = tid & 63, kg = tid >> 6;
    const float* w = INP(4) + (size_t)l * 1024 * 9216 + j0 + jc;
    float acc[9];
#pragma unroll
    for (int r = 0; r < 9; ++r) acc[r] = 0.f;
#pragma unroll 16
    for (int k = kg * 128; k < kg * 128 + 128; ++k) {
        const float wv = w[(size_t)k * 9216];
        const f32x4 s0 = *(const LAS f32x4*)(s + k * 12), s1 = *(const LAS f32x4*)(s + k * 12 + 4); const float s8 = s[k * 12 + 8];
        acc[0] += s0[0] * wv; acc[1] += s0[1] * wv; acc[2] += s0[2] * wv; acc[3] += s0[3] * wv;
        acc[4] += s1[0] * wv; acc[5] += s1[1] * wv; acc[6] += s1[2] * wv; acc[7] += s1[3] * wv; acc[8] += s8 * wv;
    }
#pragma unroll
    for (int r = 0; r < 9; ++r) red[(kg * 9 + r) * 64 + jc] = acc[r];
    __syncthreads();
    float* mod = (float*)(WSP() + OFF_MOD) + (size_t)l * 9 * 9216;
    const float* adab = INP(5);
    for (int idx = tid; idx < 9 * 64; idx += NTHR) {
        const int r = idx >> 6, c = idx & 63;
        float v = adab[l * 9216 + j0 + c];
#pragma unroll
        for (int g = 0; g < 8; ++g) v += red[(g * 9 + r) * 64 + c];
        mod[(size_t)r * 9216 + j0 + c] = v;
    }
}

DI void filt_item(const Params& p, int it, LAS unsigned char* lds) {
    const int tid = otid();
    const int l = it / 136; int r = it % 136;
    const int which = r < 128 ? 0 : 1; if (which) r -= 128;
    const int n = which ? 256 : 4096, t0 = r * 32;
    LAS float* z = (LAS float*)lds;
    LAS float* hA = z + 32 * 33;
    LAS float* hB = hA + 32 * 64;
    LAS bf16_t* ot = (LAS bf16_t*)(hB + 32 * 64);
    for (int idx = tid; idx < 32 * 33; idx += NTHR) {
        const int tt = idx / 33, e = idx % 33, ti = t0 + tt;
        float v;
        if (e == 0) v = (float)ti / (float)(n - 1);
        else {
            const int j = (e - 1) & 15;
            const float f = 1e-4f + (float)j * ((15.f - 1e-4f) / 15.f);
            const float w = 6.283185307179586f * (float)ti / (float)n;
            const float a = f * w;
            v = e <= 16 ? cosf(a) : -sinf(a);
        }
        z[idx] = v;
    }
    __syncthreads();
    const float* W1 = INP(18) + l * 33 * 64; const float* B1 = INP(19) + l * 64;
    const float* W2 = INP(20) + l * 64 * 64; const float* B2 = INP(21) + l * 64;
    const float* W3 = INP(22) + l * 64 * 64; const float* B3 = INP(23) + l * 64;
    const float* W4 = INP(24) + l * 64 * 512; const float* FR = INP(25) + l * 64;
    {
        const int j = tid & 63, t8 = tid >> 6;
        float a[4];
#pragma unroll
        for (int q = 0; q < 4; ++q) a[q] = B1[j];
#pragma unroll 11
        for (int e = 0; e < 33; ++e) { const float wv = W1[e * 64 + j];
#pragma unroll
            for (int q = 0; q < 4; ++q) a[q] += z[(t8 + 8 * q) * 33 + e] * wv; }
        const float fr = FR[j];
#pragma unroll
        for (int q = 0; q < 4; ++q) hA[(t8 + 8 * q) * 64 + j] = sinf(fr * a[q]);
        __syncthreads();
#pragma unroll
        for (int q = 0; q < 4; ++q) a[q] = B2[j];
#pragma unroll 16
        for (int e = 0; e < 64; ++e) { const float wv = W2[e * 64 + j];
#pragma unroll
            for (int q = 0; q < 4; ++q) a[q] += hA[(t8 + 8 * q) * 64 + e] * wv; }
#pragma unroll
        for (int q = 0; q < 4; ++q) hB[(t8 + 8 * q) * 64 + j] = sinf(fr * a[q]);
        __syncthreads();
#pragma unroll
        for (int q = 0; q < 4; ++q) a[q] = B3[j];
#pragma unroll 16
        for (int e = 0; e < 64; ++e) { const float wv = W3[e * 64 + j];
#pragma unroll
            for (int q = 0; q < 4; ++q) a[q] += hB[(t8 + 8 * q) * 64 + e] * wv; }
#pragma unroll
        for (int q = 0; q < 4; ++q) hA[(t8 + 8 * q) * 64 + j] = sinf(fr * a[q]);
        __syncthreads();
    }
    {
        const int col = tid, c = col & 255;
        const float a0 = -3.0701134573253942f, a1 = -15.350567286626972f;
        const float delta = fabsf(a0 + (float)c * ((a1 - a0) / 255.f));
        float part = 0.f;
        float w4r[64];
#pragma unroll
        for (int e = 0; e < 64; ++e) w4r[e] = W4[e * 512 + col];
#pragma unroll 1
        for (int tt = 0; tt < 32; ++tt) {
            float a = 0.f;
#pragma unroll
            for (int e = 0; e < 64; e += 4) { const f32x4 hv = *(const LAS f32x4*)(hA + tt * 64 + e);
                a += hv[0] * w4r[e] + hv[1] * w4r[e + 1] + hv[2] * w4r[e + 2] + hv[3] * w4r[e + 3]; }
            const int ti = t0 + tt;
            const float tl = (float)ti / (float)(n - 1);
            float v = a * __expf(-tl * delta);
            if (col >= 256 && ti == 0) v = 0.f;
            part += fabsf(v);
            ot[col * 32 + tt] = f2bf(v);
        }
        float* pp = which ? (float*)(WSP() + OFF_PARTC) + ((size_t)l * 8 + r) * 512 : (float*)(WSP() + OFF_PART) + ((size_t)l * 128 + r) * 512;
        pp[col] = part;
    }
    __syncthreads();
    bf16_t* kf = which ? (bf16_t*)(WSP() + OFF_KFC) + (size_t)l * 256 * 512 : (bf16_t*)(WSP() + OFF_KF) + (size_t)l * 256 * 8192;
    for (int idx = tid; idx < 512 * 32; idx += NTHR) {
        const int col = idx >> 5, tt = idx & 31, ti = t0 + tt, c = col & 255;
        const bf16_t v = ot[col * 32 + tt];
        if (col < 256) kf[(size_t)c * (2 * n) + n + ti] = v;
        else if (ti == 0) kf[(size_t)c * (2 * n)] = 0;
        else kf[(size_t)c * (2 * n) + n - ti] = v;
    }
}

DI void rope_item(const Params& p, int it) {
    const int e = it * NTHR + otid();
    const int pos = e / 48, a = e % 48;
    const int row = pos >> 6, col = pos & 63;
    float inv, coord;
    if (a < 32) { const int f = a & 15; inv = powf(10000.f, -(float)f / 16.f); coord = (float)(a < 16 ? row : col); }
    else { const int a2 = a - 32, f = a2 & 7; inv = powf(10000.f, -(float)f / 8.f); coord = (float)(a2 < 8 ? row : col); }
    const float ang = coord * inv;
    f32x2 cs = {cosf(ang), sinf(ang)};
    ((f32x2*)(WSP() + OFF_ROPE))[e] = cs;
}

#ifndef PPROBE
#define PPROBE 0
#endif
DI void phase_p0a(const Params& p, LAS unsigned char* lds) {
    constexpr int NMODI = 288, NFILT = 272, NROPE = 384, NCONV = 2 * 2568;
    constexpr int TOTAL = NMODI + NFILT + NROPE + NCONV;
    for (int it = obid(); it < TOTAL; it += gridDim.x) {
        unsigned long long pt0_ = 0; if (PPROBE) pt0_ = __builtin_amdgcn_s_memrealtime();
        if (it < NMODI) mod_item(p, it, lds);
        else if (it < NMODI + NFILT) filt_item(p, it - NMODI, lds);
        else if (it < NMODI + NFILT + NROPE) rope_item(p, it - NMODI - NFILT);
        else conv_item(p, it - NMODI - NFILT - NROPE, lds);
        __syncthreads();
        if (PPROBE) { const int ty = it < NMODI ? 1 : (it < NMODI + NFILT ? 2 : (it < NMODI + NFILT + NROPE ? 4 : 8));
            if ((PPROBE & ty) && threadIdx.x == 0) *(LAS unsigned long long*)(lds + LDS_BYTES - 32) += __builtin_amdgcn_s_memrealtime() - pt0_; }
    }
}

DI void phase_ln(const Params& p, int M, bool first, const float* g, const float* bta, bool do_mod, int lmod, int i_shift, int i_scale, bool write_out, int row0 = 0, int vb0 = 0, int vG = 0, const bf16_t* Yd = nullptr, bool from_in = false) {
    const int tid_ = otid(); const int lane = tid_ & 63, wv = tid_ >> 6;
    float* X = (float*)(WSP() + OFF_X);
    bf16_t* H = (bf16_t*)(WSP() + OFF_R1);
    const float* mod = (const float*)(WSP() + OFF_MOD) + (size_t)lmod * 9 * 9216;
    const int Gl = vG > 0 ? vG : (int)gridDim.x, vbl = obid() - vb0;
    if (vbl < 0 || vbl >= Gl) return;
    const bool rd_in = first || from_in;
    const float* xin = rd_in ? INP(0) : nullptr; const float* cin = rd_in ? INP(2) : nullptr;
    const float in_sc = from_in ? ALPHA : 1.f;
#define LN_LOAD(r, dst) do { const float* src_ = rd_in ? ((r) < MLAT ? xin + (size_t)(r) * D : cin + (size_t)((r) - MLAT) * D) : X + (size_t)(r) * D; \
        _Pragma("unroll") for (int q = 0; q < 4; ++q) dst[q] = in_sc * *(const f32x4*)(src_ + q * 256 + lane * 4); \
        if (Yd != nullptr) { _Pragma("unroll") for (int q = 0; q < 4; ++q) { const u32x2 y_ = *(const u32x2*)(Yd + (size_t)(r) * D + q * 256 + lane * 4); \
            dst[q] = dst[q] + (f32x4){__uint_as_float(y_.x << 16), __uint_as_float(y_.x & 0xffff0000u), __uint_as_float(y_.y << 16), __uint_as_float(y_.y & 0xffff0000u)}; } } } while (0)
    const int rstep = Gl * 8;
    float* outp = write_out ? OUTP() : nullptr;
    f32x4 gg4[4], bb4[4];
#pragma unroll
    for (int q = 0; q < 4; ++q) { gg4[q] = (f32x4){1.f, 1.f, 1.f, 1.f}; bb4[q] = (f32x4){0.f, 0.f, 0.f, 0.f}; }
    if (!first) {
#pragma unroll
        for (int q = 0; q < 4; ++q) { gg4[q] = *(const f32x4*)(g + q * 256 + lane * 4); bb4[q] = *(const f32x4*)(bta + q * 256 + lane * 4); }
    }
    f32x4 v[4], vn[4];
    { const int r0_ = row0 + vbl * 8 + wv; if (r0_ < M) LN_LOAD(r0_, v); }
    for (int row = row0 + vbl * 8 + wv; row < M; row += rstep) {
        const bool more = row + rstep < M;
        if (more) LN_LOAD(row + rstep, vn);
        f32x4 sc4[4], sh4[4];
        if (do_mod) {
            const int bi_ = row < MLAT ? (row >> 12) : 8;
            const float* sh_ = mod + (size_t)bi_ * 9216 + i_shift * 1024; const float* sc_ = mod + (size_t)bi_ * 9216 + i_scale * 1024;
#pragma unroll
            for (int q = 0; q < 4; ++q) { sc4[q] = *(const f32x4*)(sc_ + q * 256 + lane * 4); sh4[q] = *(const f32x4*)(sh_ + q * 256 + lane * 4); }
        }
        if (!first) {
            float s = 0.f;
#pragma unroll
            for (int q = 0; q < 4; ++q) s += (v[q][0] + v[q][1]) + (v[q][2] + v[q][3]);
            const float mu = wave_sum(s) * (1.f / 1024.f);
            float ss = 0.f;
#pragma unroll
            for (int q = 0; q < 4; ++q) { const f32x4 d = v[q] - mu; ss += (d[0] * d[0] + d[1] * d[1]) + (d[2] * d[2] + d[3] * d[3]); }
            const float rstd = rsqrtf(wave_sum(ss) * (1.f / 1024.f) + EPS);
#pragma unroll
            for (int q = 0; q < 4; ++q) {
                v[q] = (v[q] - mu) * rstd * gg4[q] + bb4[q];
            }
        }
#pragma unroll
        for (int q = 0; q < 4; ++q) if (!write_out && !first) *(f32x4*)(X + (size_t)row * D + q * 256 + lane * 4) = ALPHA * v[q];
        if (write_out && row < MLAT) {
#pragma unroll
            for (int q = 0; q < 4; ++q) *(f32x4*)(outp + (size_t)row * D + q * 256 + lane * 4) = v[q];
        }
        if (do_mod) {
            float s = 0.f;
#pragma unroll
            for (int q = 0; q < 4; ++q) s += (v[q][0] + v[q][1]) + (v[q][2] + v[q][3]);
            const float mu = wave_sum(s) * (1.f / 1024.f);
            float ss = 0.f;
#pragma unroll
            for (int q = 0; q < 4; ++q) { const f32x4 d = v[q] - mu; ss += (d[0] * d[0] + d[1] * d[1]) + (d[2] * d[2] + d[3] * d[3]); }
            const float rstd = rsqrtf(wave_sum(ss) * (1.f / 1024.f) + EPS);
#pragma unroll
            for (int q = 0; q < 4; ++q) {
                const f32x4 s4 = sc4[q], h4 = sh4[q];
                const f32x4 o = (v[q] - mu) * rstd * (1.f + s4) + h4;
                u32x2 w; w.x = pack2(o[0], o[1]); w.y = pack2(o[2], o[3]);
                *(u32x2*)(H + (size_t)row * D + q * 256 + lane * 4) = w;
            }
        }
        if (more) {
#pragma unroll
            for (int q = 0; q < 4; ++q) v[q] = vn[q];
        }
    }
#undef LN_LOAD
}

namespace gm {
constexpr int BM = 256, BK = 64, HALF = 128, HTB = HALF * BK * 2, NXCD = 8, WGM = 8;
DI int lds_byte(int r, int c) { const int st = (r >> 4) * 2 + (c >> 5), rr = r & 15, cc = c & 31, ob = rr * 64 + cc * 2; return st * 1024 + (ob ^ (((ob >> 9) & 1) << 5)); }
DI void stage_rc(int b, int& R, int& C) { const int st = b / 1024, sb = b % 1024, swz = sb ^ (((sb >> 9) & 1) << 5); R = (st >> 1) * 16 + swz / 64; C = (st & 1) * 32 + (swz % 64) / 2; }

struct EpiSwiglu {
    static constexpr bool SPLITK = false;
    bf16_t* act;
    DI void operator()(const f32x4 (&acc)[2][2][4][2], int pm, int pn, int wr, int wc, int fr, int fq, bool) const {
        const int unit0 = pn * 128 + wc * 32 + fq * 8;
#pragma unroll
        for (int ai = 0; ai < 2; ++ai)
#pragma unroll
            for (int m = 0; m < 4; ++m) {
                const int row = pm * 256 + ai * 128 + wr * 64 + m * 16 + fr;
                float o[8];
#pragma unroll
                for (int bj = 0; bj < 2; ++bj) {
                    const f32x4 gt = acc[ai][bj][m][0], up = acc[ai][bj][m][1];
#pragma unroll
                    for (int j = 0; j < 4; ++j) o[bj * 4 + j] = gt[j] * __builtin_amdgcn_rcpf(1.f + __expf(-gt[j])) * up[j];
                }
                u32x4 w; w.x = pack2(o[0], o[1]); w.y = pack2(o[2], o[3]); w.z = pack2(o[4], o[5]); w.w = pack2(o[6], o[7]);
                *(u32x4*)(act + (size_t)row * DFF + unit0) = w;
            }
    }
};
struct EpiResid {
    static constexpr bool SPLITK = false;
    bf16_t* Y; const float* gate; float coef;
    DI void operator()(const f32x4 (&acc)[2][2][4][2], int pm, int pn, int wr, int wc, int fr, int fq, bool) const {
        const int row0 = pm * 256 + wr * 64 + fr;
        const int bi = row0 < MLAT ? (row0 >> 12) : 8;
        const int col0 = pn * 256 + wc * 32 + fq * 8;
        f32x4 gv[2][2];
#pragma unroll
        for (int bj = 0; bj < 2; ++bj)
#pragma unroll
            for (int n = 0; n < 2; ++n) gv[bj][n] = coef * *(const f32x4*)(gate + (size_t)bi * 9216 + col0 + bj * 128 + n * 4);
#pragma unroll
        for (int ai = 0; ai < 2; ++ai)
#pragma unroll
            for (int m = 0; m < 4; ++m) {
                bf16_t* yp = Y + (size_t)(row0 + ai * 128 + m * 16) * D + col0;
#pragma unroll
                for (int bj = 0; bj < 2; ++bj) {
                    const f32x4 a = gv[bj][0] * acc[ai][bj][m][0], b = gv[bj][1] * acc[ai][bj][m][1];
                    u32x4 w; w.x = pack2(a[0], a[1]); w.y = pack2(a[2], a[3]); w.z = pack2(b[0], b[1]); w.w = pack2(b[2], b[3]);
                    *(u32x4*)(yp + bj * 128) = w;
                }
            }
    }
};
struct EpiWin {
    static constexpr bool SPLITK = false;
    bf16_t* pa; bf16_t* pbb; bf16_t* pc;
    DI void operator()(const f32x4 (&acc)[2][2][4][2], int pm, int pn, int wr, int wc, int fr, int fq, bool) const {
#pragma unroll
        for (int ai = 0; ai < 2; ++ai)
#pragma unroll
            for (int m = 0; m < 4; ++m) {
                const int row = pm * 256 + ai * 128 + wr * 64 + m * 16 + fr;
#pragma unroll
                for (int bj = 0; bj < 2; ++bj) {
                    const int col = pn * 256 + bj * 128 + wc * 32 + fq * 8;
                    const f32x4 a = acc[ai][bj][m][0], b = acc[ai][bj][m][1];
                    u32x4 w; w.x = pack2(a[0], a[1]); w.y = pack2(a[2], a[3]); w.z = pack2(b[0], b[1]); w.w = pack2(b[2], b[3]);
                    if (col < 640) *(u32x4*)(pa + (size_t)row * 640 + col) = w;
                    else if (col < 1408) *(u32x4*)(pbb + (size_t)row * 768 + (col - 640)) = w;
                    else if (col < 1824) *(u32x4*)(pc + (size_t)row * 416 + (col - 1408)) = w;
                }
            }
    }
};
struct EpiUp {
    static constexpr bool SPLITK = false;
    bf16_t* upb; float qscale;
    DI void operator()(const f32x4 (&acc)[2][2][4][2], int pm, int pn, int wr, int wc, int fr, int fq, bool) const {
#pragma unroll
        for (int ai = 0; ai < 2; ++ai)
#pragma unroll
            for (int m = 0; m < 4; ++m) {
                const int row = pm * 256 + ai * 128 + wr * 64 + m * 16 + fr;
#pragma unroll
                for (int bj = 0; bj < 2; ++bj) {
                    const int col = pn * 256 + bj * 128 + wc * 32 + fq * 8;
                    if (col < 1344) {
                        const float sc = col < 576 ? qscale : 1.f;
                        const f32x4 a = acc[ai][bj][m][0] * sc, b = acc[ai][bj][m][1] * sc;
                        u32x4 w; w.x = pack2(a[0], a[1]); w.y = pack2(a[2], a[3]); w.z = pack2(b[0], b[1]); w.w = pack2(b[2], b[3]);
                        *(u32x4*)(upb + (size_t)row * 1344 + col) = w;
                    }
                }
            }
    }
};

#define G_SA(b, h) (((b) * 2 + (h)) * HTB)
#define G_SB(b, h) ((4 + (b) * 2 + (h)) * HTB)
#define G_STAGE(bufoff, gbase, voff) do { _Pragma("unroll") for (int _i = 0; _i < 2; ++_i) \
        __builtin_amdgcn_global_load_lds((const unsigned*)((const char*)(gbase) + (voff)[_i]), (LAS unsigned*)(lds + (bufoff) + ldsw + _i * 8192), 16, 0, 0); } while (0)
#define G_LDA(dst, b, h) do { _Pragma("unroll") for (int m = 0; m < 4; ++m) _Pragma("unroll") for (int k = 0; k < 2; ++k) dst[m][k] = *(const LAS bf16x8*)(lds + G_SA(b, h) + aoff + m * 2048 + k * 1024); } while (0)
#define G_LDB(dst, b, h) do { _Pragma("unroll") for (int n = 0; n < 2; ++n) _Pragma("unroll") for (int k = 0; k < 2; ++k) dst[n][k] = *(const LAS bf16x8*)(lds + G_SB(b, h) + boff + n * 2048 + k * 1024); } while (0)
#define G_MMA(ai, bj, At, Bt) do { __builtin_amdgcn_s_setprio(1); _Pragma("unroll") for (int m = 0; m < 4; ++m) _Pragma("unroll") for (int n = 0; n < 2; ++n) _Pragma("unroll") for (int k = 0; k < 2; ++k) \
        acc[ai][bj][m][n] = __builtin_amdgcn_mfma_f32_16x16x32_bf16(Bt[n][k], At[m][k], acc[ai][bj][m][n], 0, 0, 0); __builtin_amdgcn_s_setprio(0); } while (0)
#define G_WAIT_V(n) asm volatile("s_waitcnt vmcnt(" #n ")" ::: "memory")
#define G_WAIT_L(n) asm volatile("s_waitcnt lgkmcnt(" #n ")" ::: "memory")
#define G_BAR __builtin_amdgcn_s_barrier()
#define G_SCHED __builtin_amdgcn_sched_barrier(0)

template <class Epi>
DI void gemm_phase(LAS unsigned char* lds, const bf16_t* A, int lda, const bf16_t* Bt, int ldb, int M, int N, int K, const Epi& epi, int pm0 = 0, int vb0 = 0, int vG = 0) {
    const int tid = otid(), wid = __builtin_amdgcn_readfirstlane(tid >> 6), lane = tid & 63, wr = wid >> 2, wc = wid & 3, fr = lane & 15, fq = lane >> 4;
    const int nt = K / BK, nM = M / BM, nN = N / BM, nwg = nM * nN;
    const int G = vG > 0 ? vG : (int)gridDim.x;
    const int vb = obid() - vb0;
    if (vb < 0 || vb >= G || vb >= nwg) return;
    unsigned voffA[2], voffB[2];
#pragma unroll
    for (int i = 0; i < 2; ++i) { int R, C; stage_rc(tid * 16 + i * 8192, R, C); voffA[i] = (unsigned)(R * lda + C) * 2u; voffB[i] = (unsigned)(R * ldb + C) * 2u; }
    const unsigned ldsw = (unsigned)wid * 1024u;
    const int aoff = lds_byte(wr * 64 + fr, fq * 8), boff = lds_byte(wc * 32 + fr, fq * 8);
    const size_t kstep = (size_t)(BK * 2), hA = (size_t)HALF * lda * 2, hB = (size_t)HALF * ldb * 2;
#define G_COORDS(Lx, pmx, pnx) do { int wgid = (Lx); \
        { const int q = nwg / NXCD, r = nwg % NXCD, xcd = wgid % NXCD, off = wgid / NXCD; wgid = (xcd < r ? xcd * (q + 1) : r * (q + 1) + (xcd - r) * q) + off; } \
        const int nig = WGM * nN, gid = wgid / nig, fm = gid * WGM, gsz = (nM - fm) < WGM ? (nM - fm) : WGM; \
        pmx = pm0 + fm + ((wgid % nig) % gsz); pnx = (wgid % nig) / gsz; } while (0)
    int pm, pn; G_COORDS(vb, pm, pn);
    const char* cA = (const char*)(A + (size_t)pm * BM * lda);
    const char* cB = (const char*)(Bt + (size_t)pn * BM * ldb);
    f32x4 acc[2][2][4][2];
#pragma unroll
    for (int a = 0; a < 2; ++a)
#pragma unroll
        for (int b = 0; b < 2; ++b)
#pragma unroll
            for (int m = 0; m < 4; ++m)
#pragma unroll
                for (int n = 0; n < 2; ++n) acc[a][b][m][n] = (f32x4){0.f, 0.f, 0.f, 0.f};
    bf16x8 At[4][2], B0[2][2], B1[2][2];
    G_STAGE(G_SB(0, 0), cB, voffB); G_STAGE(G_SB(0, 1), cB + hB, voffB); G_STAGE(G_SA(0, 0), cA, voffA); G_STAGE(G_SA(0, 1), cA + hA, voffA);
    if (wr == 1) G_BAR;
    G_WAIT_V(2); G_BAR;
    G_STAGE(G_SB(1, 0), cB + kstep, voffB); G_STAGE(G_SA(1, 0), cA + kstep, voffA); G_STAGE(G_SB(1, 1), cB + hB + kstep, voffB);
    G_WAIT_V(6); G_BAR;
    for (int wu = vb;;) {
        const int wn = wu + G;
        const bool has_next = wn < nwg;
        int pmn = pm, pnn = pn;
        if (has_next) G_COORDS(wn, pmn, pnn);
        const char* nA = has_next ? (const char*)(A + (size_t)pmn * BM * lda) : cA;
        const char* nB = has_next ? (const char*)(Bt + (size_t)pnn * BM * ldb) : cB;
        for (int t = 0; t < nt; t += 2) {
            const bool last = (t == nt - 2);
            const char* a1 = cA + (size_t)(t + 1) * kstep;
            const char* a2 = last ? nA : cA + (size_t)(t + 2) * kstep; const char* b2 = last ? nB : cB + (size_t)(t + 2) * kstep;
            const char* a3 = a2 + kstep; const char* b3 = b2 + kstep;
            G_LDB(B0, 0, 0); G_LDB(B1, 0, 1); G_SCHED; G_LDA(At, 0, 0); G_STAGE(G_SA(1, 1), a1 + hA, voffA);
            G_WAIT_V(8); G_WAIT_L(0); G_BAR; G_MMA(0, 0, At, B0); G_MMA(0, 1, At, B1); G_BAR; G_SCHED;
            G_LDA(At, 0, 1); G_STAGE(G_SB(0, 0), b2, voffB); G_STAGE(G_SB(0, 1), b2 + hB, voffB); G_STAGE(G_SA(0, 0), a2, voffA);
            G_WAIT_V(8); G_WAIT_L(0); G_BAR; G_MMA(1, 0, At, B0); G_MMA(1, 1, At, B1); G_BAR; G_SCHED;
            G_LDB(B0, 1, 0); G_LDB(B1, 1, 1); G_SCHED; G_LDA(At, 1, 0); G_STAGE(G_SA(0, 1), a2 + hA, voffA);
            G_WAIT_V(8); G_WAIT_L(0); G_BAR; G_MMA(0, 0, At, B0); G_MMA(0, 1, At, B1); G_BAR; G_SCHED;
            G_LDA(At, 1, 1); G_STAGE(G_SB(1, 0), b3, voffB); G_STAGE(G_SB(1, 1), b3 + hB, voffB); G_STAGE(G_SA(1, 0), a3, voffA);
            G_WAIT_V(8); G_WAIT_L(0); G_BAR; G_MMA(1, 0, At, B0); G_MMA(1, 1, At, B1); G_BAR; G_SCHED;
        }
        if (wr == 0) G_BAR;
        epi(acc, pm, pn, wr, wc, fr, fq, false);
        if (!has_next) break;
#pragma unroll
        for (int a = 0; a < 2; ++a)
#pragma unroll
            for (int b = 0; b < 2; ++b)
#pragma unroll
                for (int m = 0; m < 4; ++m)
#pragma unroll
                    for (int n = 0; n < 2; ++n) acc[a][b][m][n] = (f32x4){0.f, 0.f, 0.f, 0.f};
        pm = pmn; pn = pnn; cA = nA; cB = nB; wu = wn;
        if (wr == 1) G_BAR;
    }
    G_WAIT_V(0);
    G_BAR;
#undef G_COORDS
    __syncthreads();
}
}


DI void phase_post(const Params& p, int l, LAS unsigned char* lds) {
    const int tid_ = otid(); const int lane = tid_ & 63, wv = tid_ >> 6;
    bf16_t* PA = (bf16_t*)(WSP() + OFF_PA);
    const bf16_t* PBB = (const bf16_t*)(WSP() + OFF_PBB);
    const bf16_t* PC = (const bf16_t*)(WSP() + OFF_PC);
    bf16_t* HYU = (bf16_t*)(WSP() + OFF_HYU);
    bf16_t* HYX = (bf16_t*)(WSP() + OFF_HYX);
    bf16_t* KR = (bf16_t*)(WSP() + OFF_KR);
    bf16_t* CN = (bf16_t*)(WSP() + OFF_R1);
    const f32x2* ROPE = (const f32x2*)(WSP() + OFF_ROPE);
    const int hd = lane >> 3, e0 = (lane & 7) * 8;
    float g8[8];
#pragma unroll
    for (int j = 0; j < 8; ++j) g8[j] = (hd < 6 ? INP(14)[l * 64 + e0 + j] : INP(15)[l * 64 + e0 + j]) * (hd < 6 ? 0.125f * LOG2E : 1.f);
    const float* cw = INP(16) + (size_t)l * 3 * 768;
    const float* cb = INP(17) + (size_t)l * 768;
    f32x4 w0[3], w1[3], w2[3], wb[3];
#pragma unroll
    for (int g3 = 0; g3 < 3; ++g3) {
        const int col = g3 * 256 + 4 * lane;
        w0[g3] = *(const f32x4*)(cw + col); w1[g3] = *(const f32x4*)(cw + 768 + col); w2[g3] = *(const f32x4*)(cw + 1536 + col); wb[g3] = *(const f32x4*)(cb + col);
    }
    LAS bf16_t* UT = (LAS bf16_t*)lds;
    LAS bf16_t* XT = UT + 256 * 40;
    for (int tile = obid(); tile < MTOT / 32; tile += gridDim.x) {
      for (int tq = 0; tq < 4; ++tq) {
        const int tt = wv * 4 + tq, tok = tile * 32 + tt;
        const bool lat = tok < MLAT;
        const int t = lat ? (tok & 4095) : ((tok - MLAT) & 255);
        const int n = lat ? SEQ : CTXL;
        bf16_t* pa = PA + (size_t)tok * 640 + lane * 8;
        const u32x4 raw = *(const u32x4*)pa;
        const bf16_t* r0 = PBB + (size_t)tok * 768 + 4 * lane;
        u32x2 c0v[3], cmv[3], cpv[3];
#pragma unroll
        for (int g3 = 0; g3 < 3; ++g3) {
            c0v[g3] = *(const u32x2*)(r0 + g3 * 256);
            cmv[g3] = (u32x2){0u, 0u}; cpv[g3] = (u32x2){0u, 0u};
            if (t > 0) cmv[g3] = *(const u32x2*)(r0 + g3 * 256 - 768);
            if (t < n - 1) cpv[g3] = *(const u32x2*)(r0 + g3 * 256 + 768);
        }
        const bf16_t* pc = PC + (size_t)tok * 416;
        const u32x2 cq = *(const u32x2*)(pc + 4 * lane);
        const unsigned ck = *(const unsigned*)(pc + 256 + 2 * lane);
        const bf16_t krraw = pc[384 + (lane & 31)];
        f32x2 csa[8]; f32x2 csk = {1.f, 0.f};
        if (lat) {
            const f32x2* cs = ROPE + (size_t)t * 48 + (lane & 3) * 8;
#pragma unroll
            for (int j = 0; j < 8; ++j) csa[j] = cs[j];
            csk = ROPE[(size_t)t * 48 + 32 + (lane & 15)];
        }
        {
            float x[8];
#pragma unroll
            for (int j = 0; j < 4; ++j) { x[2 * j] = __uint_as_float(raw[j] << 16); x[2 * j + 1] = __uint_as_float(raw[j] & 0xffff0000u); }
            float ss = 0.f;
#pragma unroll
            for (int j = 0; j < 8; ++j) ss += x[j] * x[j];
            ss += __shfl_xor(ss, 1); ss += __shfl_xor(ss, 2); ss += __shfl_xor(ss, 4);
            const float r = rsqrtf(ss * (1.f / 64.f) + EPS);
#pragma unroll
            for (int j = 0; j < 8; ++j) x[j] *= r * g8[j];
            if (lat) {
#pragma unroll
                for (int j = 0; j < 8; ++j) {
                    const float pr = __shfl_xor(x[j], 4);
                    const f32x2 c = csa[j];
                    x[j] = (lane & 4) ? x[j] * c[0] + pr * c[1] : x[j] * c[0] - pr * c[1];
                }
            }
            u32x4 o; o.x = pack2(x[0], x[1]); o.y = pack2(x[2], x[3]); o.z = pack2(x[4], x[5]); o.w = pack2(x[6], x[7]);
            *(u32x4*)pa = o;
        }
        {
            f32x4 o[3];
#pragma unroll
            for (int g3 = 0; g3 < 3; ++g3) {
                const u32x2 c0 = c0v[g3], cm = cmv[g3], cp = cpv[g3];
                const f32x4 vm = {__uint_as_float(cm.x << 16), __uint_as_float(cm.x & 0xffff0000u), __uint_as_float(cm.y << 16), __uint_as_float(cm.y & 0xffff0000u)};
                const f32x4 v0 = {__uint_as_float(c0.x << 16), __uint_as_float(c0.x & 0xffff0000u), __uint_as_float(c0.y << 16), __uint_as_float(c0.y & 0xffff0000u)};
                const f32x4 vp = {__uint_as_float(cp.x << 16), __uint_as_float(cp.x & 0xffff0000u), __uint_as_float(cp.y << 16), __uint_as_float(cp.y & 0xffff0000u)};
                o[g3] = w0[g3] * vm + w1[g3] * v0 + w2[g3] * vp + wb[g3];
            }
            const f32x4 u = o[0] * o[1];
            u32x2 a; a.x = pack2(u[0], u[1]); a.y = pack2(u[2], u[3]);
            u32x2 b; b.x = pack2(o[2][0], o[2][1]); b.y = pack2(o[2][2], o[2][3]);
#pragma unroll
            for (int j = 0; j < 4; ++j) {
                const unsigned ua = (j & 1) ? ((j < 2 ? a.x : a.y) >> 16) : ((j < 2 ? a.x : a.y) & 0xffffu);
                const unsigned ub = (j & 1) ? ((j < 2 ? b.x : b.y) >> 16) : ((j < 2 ? b.x : b.y) & 0xffffu);
                UT[(4 * lane + j) * 40 + tt] = (bf16_t)ua; XT[(4 * lane + j) * 40 + tt] = (bf16_t)ub;
            }
        }
        {
            const f32x4 v = {__uint_as_float(cq.x << 16), __uint_as_float(cq.x & 0xffff0000u), __uint_as_float(cq.y << 16), __uint_as_float(cq.y & 0xffff0000u)};
            const float rq = rsqrtf(wave_sum((v[0] * v[0] + v[1] * v[1]) + (v[2] * v[2] + v[3] * v[3])) * (1.f / 256.f) + EPS);
            u32x2 oq; oq.x = pack2(v[0] * rq, v[1] * rq); oq.y = pack2(v[2] * rq, v[3] * rq);
            *(u32x2*)(CN + (size_t)tok * 384 + 4 * lane) = oq;
            const float u0 = __uint_as_float(ck << 16), u1 = __uint_as_float(ck & 0xffff0000u);
            const float rk = rsqrtf(wave_sum(u0 * u0 + u1 * u1) * (1.f / 128.f) + EPS);
            *(unsigned*)(CN + (size_t)tok * 384 + 256 + 2 * lane) = pack2(u0 * rk, u1 * rk);
            float kr = bf2f(krraw);
            const float pr = __shfl_xor(kr, 16);
            if (lat) kr = (lane & 16) ? kr * csk[0] + pr * csk[1] : kr * csk[0] - pr * csk[1];
            if (lane < 32) KR[(size_t)tok * 32 + lane] = f2bf(kr);
        }
      }
      __syncthreads();
      {
          const int ch = tid_ >> 1, half = tid_ & 1;
          const u32x4 u0 = *(const LAS u32x4*)(UT + ch * 40 + 16 * half), u1 = *(const LAS u32x4*)(UT + ch * 40 + 16 * half + 8);
          const u32x4 x0 = *(const LAS u32x4*)(XT + ch * 40 + 16 * half), x1 = *(const LAS u32x4*)(XT + ch * 40 + 16 * half + 8);
          bf16_t* du = HYU + (size_t)ch * MTOT + tile * 32 + 16 * half; bf16_t* dx = HYX + (size_t)ch * MTOT + tile * 32 + 16 * half;
          *(u32x4*)du = u0; *(u32x4*)(du + 8) = u1; *(u32x4*)dx = x0; *(u32x4*)(dx + 8) = x1;
      }
      __syncthreads();
    }
}

template <int DQK>
DI void attn_item(LAS unsigned char* lds, const bf16_t* qbase, int q_ld, const bf16_t* kc, const bf16_t* kl, const bf16_t* vc, const bf16_t* vl, int kv_ld,
                  const bf16_t* krc, const bf16_t* krl, int ntiles, bf16_t* obase, const f32x2* rope) {
    constexpr int KS = DQK + 8, VS = 68, KBYTES = 64 * KS * 2, BUF = KBYTES + 64 * VS * 2, NKK = DQK / 16;
    const int tid = otid(), lane = tid & 63, w = tid >> 6, li = lane & 31, h = lane >> 5;
    bf16x8 qf[NKK];
    {
        const bf16_t* qrow = qbase + (size_t)(32 * w + li) * q_ld;
#pragma unroll
        for (int kk = 0; kk < NKK; ++kk) qf[kk] = *(const bf16x8*)(qrow + 16 * kk + 8 * h);
        if (DQK == 96 && rope != nullptr) {
            const f32x2* cs = rope + (size_t)(32 * w + li) * 48 + 8 * h;
            bf16x8 a = qf[NKK - 2], b = qf[NKK - 1];
#pragma unroll
            for (int j = 0; j < 8; ++j) {
                const float x1 = bf2f((bf16_t)a[j]), x2 = bf2f((bf16_t)b[j]);
                const f32x2 c = cs[j];
                a[j] = (short)f2bf(x1 * c[0] - x2 * c[1]);
                b[j] = (short)f2bf(x2 * c[0] + x1 * c[1]);
            }
            qf[NKK - 2] = a; qf[NKK - 1] = b;
        }
    }
    f32x16 ot[2];
#pragma unroll
    for (int i = 0; i < 16; ++i) { ot[0][i] = 0.f; ot[1][i] = 0.f; }
    float m_run = -INFINITY, l_run = 0.f;
    const int kkey = tid >> 3, kch = tid & 7;
    const int vkey = lane, vch = w;
    const int rkey = tid >> 2, rch = tid & 3;
    u32x4 kreg, vreg, rreg;
    const unsigned voffK = (unsigned)(kkey * kv_ld + 8 * kch) * 2u, voffV = (unsigned)(vkey * kv_ld + 8 * vch) * 2u, voffR = (unsigned)(rkey * 32 + 8 * rch) * 2u;
#define ATT_LOAD(j) do { const int s0 = (j) * 64; \
        const char* kb_ = (const char*)(s0 < CTXL ? kc + (size_t)s0 * kv_ld : kl + (size_t)(s0 - CTXL) * kv_ld); \
        const char* vb_ = (const char*)(s0 < CTXL ? vc + (size_t)s0 * kv_ld : vl + (size_t)(s0 - CTXL) * kv_ld); \
        kreg = *(const u32x4*)(kb_ + voffK); \
        vreg = *(const u32x4*)(vb_ + voffV); \
        if (DQK == 96 && tid < 256) { const char* rb = (const char*)(s0 < CTXL ? krc + (size_t)s0 * 32 : krl + (size_t)(s0 - CTXL) * 32); rreg = *(const u32x4*)(rb + voffR); } } while (0)
#define ATT_STORE(bufi) do { LAS unsigned char* kb_ = lds + (bufi) * BUF; LAS bf16_t* vt_ = (LAS bf16_t*)(kb_ + KBYTES); \
        *(LAS u32x4*)(kb_ + (kkey * KS + 8 * kch) * 2) = kreg; \
        if (DQK == 96 && tid < 256) *(LAS u32x4*)(kb_ + (rkey * KS + 64 + 8 * rch) * 2) = rreg; \
        _Pragma("unroll") for (int e = 0; e < 4; ++e) { const unsigned wd = vreg[e]; vt_[(8 * vch + 2 * e) * VS + vkey] = (bf16_t)(wd & 0xffffu); vt_[(8 * vch + 2 * e + 1) * VS + vkey] = (bf16_t)(wd >> 16); } } while (0)
    ATT_LOAD(0);
    ATT_STORE(0);
    __syncthreads();
    bf16x8 vf[2][2][2];
    f32x16 st[2];
#define ATT_X(j) do { \
        const LAS unsigned char* kb = lds + ((j) & 1) * BUF; const LAS unsigned char* vt = kb + KBYTES; \
        bf16x8 kf[2][NKK]; \
        _Pragma("unroll") for (int kt = 0; kt < 2; ++kt) _Pragma("unroll") for (int kk = 0; kk < NKK; ++kk) kf[kt][kk] = *(const LAS bf16x8*)(kb + ((32 * kt + li) * KS + 16 * kk + 8 * h) * 2); \
        _Pragma("unroll") for (int vtile = 0; vtile < 2; ++vtile) _Pragma("unroll") for (int kt = 0; kt < 2; ++kt) _Pragma("unroll") for (int s = 0; s < 2; ++s) { \
            const LAS unsigned char* ap = vt + ((32 * vtile + li) * VS + 32 * kt + 16 * s + 4 * h) * 2; \
            const u32x2 lo = *(const LAS u32x2*)ap, hi = *(const LAS u32x2*)(ap + 16); \
            u32x4 vv; vv.x = lo.x; vv.y = lo.y; vv.z = hi.x; vv.w = hi.y; vf[vtile][kt][s] = __builtin_bit_cast(bf16x8, vv); } \
        _Pragma("unroll") for (int kt = 0; kt < 2; ++kt) { \
            _Pragma("unroll") for (int i = 0; i < 16; ++i) st[kt][i] = 0.f; \
            _Pragma("unroll") for (int kk = 0; kk < NKK; ++kk) st[kt] = MFMA32(kf[kt][kk], qf[kk], st[kt]); } } while (0)
#define ATT_Y() do { \
        float mx = fmaxf(fmaxf(st[0][0], st[0][1]), st[0][2]); \
        _Pragma("unroll") for (int i = 3; i < 15; i += 2) mx = fmaxf(fmaxf(mx, st[0][i]), st[0][i + 1]); \
        mx = fmaxf(mx, st[0][15]); \
        _Pragma("unroll") for (int i = 0; i < 16; i += 2) mx = fmaxf(fmaxf(mx, st[1][i]), st[1][i + 1]); \
        mx = fmaxf(mx, __shfl_xor(mx, 32)); \
        if (__any(mx > m_run + 8.f)) { \
            const float m_new = fmaxf(m_run, mx); const float alpha = fast_exp2(m_run - m_new); m_run = m_new; l_run *= alpha; \
            _Pragma("unroll") for (int i = 0; i < 16; ++i) { ot[0][i] *= alpha; ot[1][i] *= alpha; } } \
        { const f32x2 m2 = {m_run, m_run}; f32x2 rs2 = {0.f, 0.f}; \
          _Pragma("unroll") for (int kt = 0; kt < 2; ++kt) _Pragma("unroll") for (int i = 0; i < 16; i += 2) { \
              f32x2 d = (f32x2){st[kt][i], st[kt][i + 1]} - m2; d[0] = fast_exp2(d[0]); d[1] = fast_exp2(d[1]); rs2 += d; st[kt][i] = d[0]; st[kt][i + 1] = d[1]; } \
          l_run += rs2[0] + rs2[1]; } \
        _Pragma("unroll") for (int kt = 0; kt < 2; ++kt) _Pragma("unroll") for (int s = 0; s < 2; ++s) { \
            u32x4 pk; pk.x = pack2(st[kt][8 * s + 0], st[kt][8 * s + 1]); pk.y = pack2(st[kt][8 * s + 2], st[kt][8 * s + 3]); \
            pk.z = pack2(st[kt][8 * s + 4], st[kt][8 * s + 5]); pk.w = pack2(st[kt][8 * s + 6], st[kt][8 * s + 7]); \
            const bf16x8 pf = __builtin_bit_cast(bf16x8, pk); \
            ot[0] = MFMA32(vf[0][kt][s], pf, ot[0]); ot[1] = MFMA32(vf[1][kt][s], pf, ot[1]); } } while (0)
    if (w < 4) {
        for (int j = 0; j < ntiles; ++j) {
            if (j + 1 < ntiles) ATT_LOAD(j + 1);
            ATT_X(j);
            __builtin_amdgcn_s_barrier();
            ATT_Y();
            if (j + 1 < ntiles) ATT_STORE((j + 1) & 1);
            asm volatile("s_waitcnt lgkmcnt(0)" ::: "memory");
            __builtin_amdgcn_s_barrier();
        }
        __builtin_amdgcn_s_barrier();
    } else {
        if (1 < ntiles) ATT_LOAD(1);
        __builtin_amdgcn_s_barrier();
        for (int j = 0; j < ntiles; ++j) {
            ATT_X(j);
            if (j + 1 < ntiles) ATT_STORE((j + 1) & 1);
            asm volatile("s_waitcnt lgkmcnt(0)" ::: "memory");
            __builtin_amdgcn_s_barrier();
            if (j + 2 < ntiles) ATT_LOAD(j + 2);
            ATT_Y();
            __builtin_amdgcn_s_barrier();
        }
    }
#undef ATT_X
#undef ATT_Y
#undef ATT_LOAD
#undef ATT_STORE
    const float lt = l_run + __shfl_xor(l_run, 32);
    const float inv = 1.f / lt;
    bf16_t* orow = obase + (size_t)(32 * w + li) * 1024;
#pragma unroll
    for (int vtile = 0; vtile < 2; ++vtile)
#pragma unroll
        for (int g4 = 0; g4 < 4; ++g4) {
            u32x2 o; o.x = pack2(ot[vtile][4 * g4 + 0] * inv, ot[vtile][4 * g4 + 1] * inv); o.y = pack2(ot[vtile][4 * g4 + 2] * inv, ot[vtile][4 * g4 + 3] * inv);
            *(u32x2*)(orow + 32 * vtile + 8 * g4 + 4 * h) = o;
        }
}

#ifndef HYPROBE
#define HYPROBE 0
#endif
template <int NBLK>
DI void hyena_item(LAS unsigned char* lds, const bf16_t* kf, float inv_norm, float dskip, const bf16_t* hyu, const bf16_t* hyx, bf16_t* mix, int tok0) {
    constexpr int n = 64 * NBLK, CL = 2 * n + 32, NCT = NBLK >= 64 ? 2 : 1;
    const int tid = otid(), lane = tid & 63, w = tid >> 6, li = lane & 31, h = lane >> 5;
    LAS bf16_t* cp = (LAS bf16_t*)lds;
    LAS bf16_t* U = cp + 4 * CL;
    for (int ch = tid; ch < (2 * n) / 8; ch += NTHR) {
        const u32x4 raw = *(const u32x4*)(kf + 8 * ch);
#pragma unroll
        for (int e = 0; e < 8; ++e) {
            const bf16_t v = (e & 1) ? (bf16_t)(raw[e >> 1] >> 16) : (bf16_t)(raw[e >> 1] & 0xffffu);
            const int x = 8 * ch + e;
#pragma unroll
            for (int r = 0; r < 4; ++r) cp[r * CL + 2 * n + 3 - r - x] = v;
        }
    }
    if (tid < 144) {
        const int r = tid / 36, k = tid % 36, idx = k < 4 ? k : 2 * n + (k - 4);
        if (idx < 4 - r || idx > 2 * n + 3 - r) cp[r * CL + idx] = (bf16_t)0;
    }
    {
        const bf16_t* hb = hyu + tok0;
        for (int i8 = tid; i8 < n; i8 += NTHR) {
            const int idx = 8 * i8, b = idx / n, s = idx % n;
            *(LAS u32x4*)(U + (b * NBLK + (s >> 6)) * 72 + (s & 63)) = *(const u32x4*)(hb + idx);
        }
    }
    __syncthreads();
    unsigned long long hyt0_ = 0; if (HYPROBE == 1) hyt0_ = __builtin_amdgcn_s_memrealtime();
    f32x16 acc[2][NCT];
#pragma unroll
    for (int mt = 0; mt < 2; ++mt)
#pragma unroll
        for (int ct = 0; ct < NCT; ++ct)
#pragma unroll
            for (int i = 0; i < 16; ++i) acc[mt][ct][i] = 0.f;
    const LAS bf16_t* Uw = U + (size_t)w * NBLK * 72;
#pragma unroll 1
    for (int d = -(NBLK - 1); d <= NBLK - 1; ++d) {
        bool act[NCT]; int blk[NCT]; bool val[NCT];
#pragma unroll
        for (int ct = 0; ct < NCT; ++ct) {
            act[ct] = (32 * ct + 31 - d >= 0) && (32 * ct - d <= NBLK - 1);
            const int a = 32 * ct + li; blk[ct] = a - d; val[ct] = (blk[ct] >= 0) && (blk[ct] < NBLK) && (a < NBLK);
        }
#pragma unroll
        for (int ks = 0; ks < 4; ++ks) {
            bf16x8 af[2];
#pragma unroll
            for (int mt = 0; mt < 2; ++mt) {
                const int y0 = n - 1 - 64 * d - (32 * mt + li) + 16 * ks + 8 * h;
                const int r = y0 & 3, m0 = y0 - r + 4;
                const LAS bf16_t* ap = cp + r * CL + m0;
                const u32x2 lo = *(const LAS u32x2*)ap, hi = *(const LAS u32x2*)(ap + 4);
                u32x4 vv; vv.x = lo.x; vv.y = lo.y; vv.z = hi.x; vv.w = hi.y;
                af[mt] = __builtin_bit_cast(bf16x8, vv);
            }
#pragma unroll
            for (int ct = 0; ct < NCT; ++ct) {
                if (act[ct]) {
                    u32x4 bv = {0u, 0u, 0u, 0u};
                    if (val[ct]) bv = *(const LAS u32x4*)(Uw + blk[ct] * 72 + 16 * ks + 8 * h);
                    const bf16x8 bfv = __builtin_bit_cast(bf16x8, bv);
                    acc[0][ct] = MFMA32(af[0], bfv, acc[0][ct]);
                    acc[1][ct] = MFMA32(af[1], bfv, acc[1][ct]);
                }
            }
        }
    }
    if (HYPROBE == 1 && NBLK == 64) { __syncthreads(); if (threadIdx.x == 0) *(LAS unsigned long long*)(lds + LDS_BYTES - 32) += __builtin_amdgcn_s_memrealtime() - hyt0_; }
#pragma unroll
    for (int mt = 0; mt < 2; ++mt)
#pragma unroll
        for (int ct = 0; ct < NCT; ++ct) {
            const int a = 32 * ct + li;
            if (a < NBLK) {
                unsigned tokb = (unsigned)(tok0 + w * n + 64 * a + 32 * mt + 4 * h);
                asm volatile("" : "+v"(tokb));
                const LAS bf16_t* up = Uw + a * 72 + 32 * mt + 4 * h;
                u32x2 xvv[4];
#pragma unroll
                for (int g = 0; g < 4; ++g) xvv[g] = *(const u32x2*)(hyx + tokb + 8u * g);
#pragma unroll
                for (int g = 0; g < 4; ++g) {
                    const unsigned tok = tokb + 8u * g;
                    const u32x2 xv = xvv[g];
                    const u32x2 uv = *(const LAS u32x2*)(up + 8 * g);
                    float o[4];
#pragma unroll
                    for (int j = 0; j < 4; ++j) {
                        const unsigned xw = j < 2 ? xv.x : xv.y, uw = j < 2 ? uv.x : uv.y;
                        const float x0 = (j & 1) ? __uint_as_float(xw & 0xffff0000u) : __uint_as_float(xw << 16);
                        const float uu = (j & 1) ? __uint_as_float(uw & 0xffff0000u) : __uint_as_float(uw << 16);
                        o[j] = (acc[mt][ct][4 * g + j] * inv_norm + uu * dskip) * x0;
                    }
                    u32x2 ov; ov.x = pack2(o[0], o[1]); ov.y = pack2(o[2], o[3]);
                    *(u32x2*)(mix + tok) = ov;
                }
            }
            __builtin_amdgcn_sched_barrier(0);
        }
}

DI void phase_mix(const Params& p, int l, bool need_ctx, LAS unsigned char* lds) {
    const bf16_t* PA = (const bf16_t*)(WSP() + OFF_PA);
    const bf16_t* UPB = (const bf16_t*)(WSP() + OFF_UPB);
    const bf16_t* KR = (const bf16_t*)(WSP() + OFF_KR);
    const bf16_t* HYU = (const bf16_t*)(WSP() + OFF_HYU);
    const bf16_t* HYX = (const bf16_t*)(WSP() + OFF_HYX);
    bf16_t* MIX = (bf16_t*)(WSP() + OFF_R1);
    const f32x2* ROPE = (const f32x2*)(WSP() + OFF_ROPE);
    const int n_items = 256 + 768 + 768 + (need_ctx ? 48 + 48 + 256 : 0);
    LAS float* red = (LAS float*)lds;
    for (int it = obid(); it < n_items; it += gridDim.x) {
        int lin = 0;
        if (it >= 256 && it < 1792) { const int j = it - 256, r = j >> 8, bp = j & 255; lin = ((r * 8 + (bp & 7)) << 5) + (bp >> 3); }
#ifndef MIXSEL
#define MIXSEL 0
#endif
        if ((MIXSEL == 0 || MIXSEL == 1) && (it < 256 || it >= 1888)) {
            const bool isl = it < 256;
            const int c = isl ? it : it - 1888;
            const float* part = isl ? (const float*)(WSP() + OFF_PART) + (size_t)l * 128 * 512 : (const float*)(WSP() + OFF_PARTC) + (size_t)l * 8 * 512;
            const int np = isl ? 128 : 8;
            float s = 0.f;
            const int tq_ = otid();
            if (tq_ < 2 * np) { const int r = tq_ >> 1, hb = tq_ & 1; s = part[(size_t)r * 512 + hb * 256 + c]; }
            s = wave_sum(s);
            __syncthreads();
            if ((tq_ & 63) == 0) red[tq_ >> 6] = s;
            __syncthreads();
            float nrm = 0.f;
#pragma unroll
            for (int i = 0; i < 8; ++i) nrm += red[i];
            __syncthreads();
            const float inv_norm = 1.f / nrm, dskip = INP(26)[l * 256 + c];
            bf16_t* OBT = (bf16_t*)(WSP() + OFF_OBT);
            if (isl) hyena_item<64>(lds, (const bf16_t*)(WSP() + OFF_KF) + ((size_t)l * 256 + c) * 8192, inv_norm, dskip, HYU + (size_t)c * MTOT, HYX + (size_t)c * MTOT, OBT + (size_t)c * MTOT, 0);
            else hyena_item<4>(lds, (const bf16_t*)(WSP() + OFF_KFC) + ((size_t)l * 256 + c) * 512, inv_norm, dskip, HYU + (size_t)c * MTOT, HYX + (size_t)c * MTOT, OBT + (size_t)c * MTOT, MLAT);
        } else if ((MIXSEL == 0 || MIXSEL == 2) && it < 1792 && lin < 768) {
            const int idx = lin, qb = idx & 15, hd = (idx >> 4) % 6, b = idx / 96, hk = hd / 3;
            const size_t tl = (size_t)b * SEQ, tc = (size_t)MLAT + (size_t)b * CTXL;
            attn_item<64>(lds, PA + (tl + qb * 256) * 640 + hd * 64, 640, PA + tc * 640 + 384 + hk * 64, PA + tl * 640 + 384 + hk * 64,
                          PA + tc * 640 + 512 + hk * 64, PA + tl * 640 + 512 + hk * 64, 640, nullptr, nullptr, 68, MIX + (tl + qb * 256) * 1024 + hd * 64, nullptr);
        } else if ((MIXSEL == 0 || MIXSEL == 3) && it < 1792) {
            const int idx = lin - 768, qb = idx & 15, hd = (idx >> 4) % 6, b = idx / 96;
            const size_t tl = (size_t)b * SEQ, tc = (size_t)MLAT + (size_t)b * CTXL;
            attn_item<96>(lds, UPB + (tl + qb * 256) * 1344 + hd * 96, 1344, UPB + tc * 1344 + 576 + hd * 128, UPB + tl * 1344 + 576 + hd * 128,
                          UPB + tc * 1344 + 576 + hd * 128 + 64, UPB + tl * 1344 + 576 + hd * 128 + 64, 1344, KR + tc * 32, KR + tl * 32, 68,
                          MIX + (tl + qb * 256) * 1024 + 640 + hd * 64, ROPE + (size_t)(qb * 256) * 48 + 32);
        } else if ((MIXSEL == 0 || MIXSEL == 2) && it < 1840) {
            const int idx = it - 1792, hd = idx % 6, b = idx / 6, hk = hd / 3;
            const size_t tc = (size_t)MLAT + (size_t)b * CTXL;
            attn_item<64>(lds, PA + tc * 640 + hd * 64, 640, PA + tc * 640 + 384 + hk * 64, PA + tc * 640 + 384 + hk * 64,
                          PA + tc * 640 + 512 + hk * 64, PA + tc * 640 + 512 + hk * 64, 640, nullptr, nullptr, 4, MIX + tc * 1024 + hd * 64, nullptr);
        } else if (MIXSEL == 0 || MIXSEL == 3) {
            const int idx = it - 1840, hd = idx % 6, b = idx / 6;
            const size_t tc = (size_t)MLAT + (size_t)b * CTXL;
            attn_item<96>(lds, UPB + tc * 1344 + hd * 96, 1344, UPB + tc * 1344 + 576 + hd * 128, UPB + tc * 1344 + 576 + hd * 128,
                          UPB + tc * 1344 + 576 + hd * 128 + 64, UPB + tc * 1344 + 576 + hd * 128 + 64, 1344, KR + tc * 32, KR + tc * 32, 4,
                          MIX + tc * 1024 + 640 + hd * 64, nullptr);
        }
        __syncthreads();
    }
}

DI void phase_untranspose(const Params& p, bool need_ctx, LAS unsigned char* lds) {
    const int tid = otid();
    const bf16_t* OBT = (const bf16_t*)(WSP() + OFF_OBT);
    bf16_t* MIX = (bf16_t*)(WSP() + OFF_R1);
    LAS bf16_t* T = (LAS bf16_t*)lds;
    const int ntile = (need_ctx ? MTOT : MLAT) / 64;
    for (int tile = obid(); tile < ntile; tile += gridDim.x) {
        {
            const int ch = tid >> 1, half = tid & 1;
            const bf16_t* src = OBT + (size_t)ch * MTOT + tile * 64 + 32 * half;
#pragma unroll
            for (int q = 0; q < 4; ++q) *(LAS u32x4*)(T + ch * 72 + 32 * half + 8 * q) = *(const u32x4*)(src + 8 * q);
        }
        __syncthreads();
        {
            const int tk = tid >> 3, cg = (tid & 7) * 32;
            unsigned w[16];
#pragma unroll
            for (int j = 0; j < 16; ++j) w[j] = (unsigned)T[(cg + 2 * j) * 72 + tk] | ((unsigned)T[(cg + 2 * j + 1) * 72 + tk] << 16);
            bf16_t* dst = MIX + (size_t)(tile * 64 + tk) * 1024 + 384 + cg;
#pragma unroll
            for (int q = 0; q < 4; ++q) { u32x4 o; o.x = w[4 * q]; o.y = w[4 * q + 1]; o.z = w[4 * q + 2]; o.w = w[4 * q + 3]; *(u32x4*)(dst + 8 * q) = o; }
        }
        __syncthreads();
    }
}

#define XB_TMO      128
#define XB_XCNT(j)  (256  + 64 * (j))
#define XB_XSUB(j)  (1280 + 64 * (j))
#define XB_XGEN(j)  (2304 + 64 * (j))
#define XB_TOP      3328
#define XB_TOPGEN   3392
#define XCD_BAR_WORDS 3456
#define XB_SPIN_CAP (1u << 22)
DI unsigned xb_ld(unsigned* p)              { return __hip_atomic_load(p, __ATOMIC_RELAXED, __HIP_MEMORY_SCOPE_AGENT); }
DI unsigned xb_add(unsigned* p, unsigned v) { return __hip_atomic_fetch_add(p, v, __ATOMIC_RELAXED, __HIP_MEMORY_SCOPE_AGENT); }
DI unsigned xb_xcc_id() { return (unsigned)__builtin_amdgcn_s_getreg((3 << 11) | 20) & 0xFu; }
#define XB_SPIN(cond, bar) do { unsigned _sp = 0; while (cond) { __builtin_amdgcn_s_sleep(1); \
    if ((++_sp & 255u) == 0u) { if (xb_ld(&(bar)[XB_TMO])) break; if (_sp > XB_SPIN_CAP) { atomicAdd(&(bar)[XB_TMO], 1u); break; } } } } while (0)
struct XcdBarrier { unsigned* bar; unsigned x; volatile LAS unsigned* st; };
DI XcdBarrier xcd_barrier_post(unsigned* bar, volatile LAS unsigned* st) {
    XcdBarrier b; b.bar = bar; b.x = xb_xcc_id(); b.st = st;
    if (threadIdx.x == 0) (void)xb_add(&bar[XB_XCNT(b.x)], 1u);
    return b;
}
DI void xcd_barrier_complete(unsigned* bar, unsigned x, unsigned& nloc, unsigned& nx) {
    const unsigned G = gridDim.x * gridDim.y * gridDim.z;
    unsigned sum, cnt, mine, sp = 0u;
    for (;;) {
        sum = 0u; cnt = 0u; mine = 0u;
#pragma unroll
        for (unsigned j = 0; j < 16; ++j) { const unsigned c = xb_ld(&bar[XB_XCNT(j)]); sum += c; cnt += (c > 0u) ? 1u : 0u; mine = (j == x) ? c : mine; }
        if (sum == G) break;
        __builtin_amdgcn_s_sleep(1);
        if ((++sp & 255u) == 0u) { if (xb_ld(&bar[XB_TMO])) break; if (sp > XB_SPIN_CAP) { atomicAdd(&bar[XB_TMO], 1u); break; } }
    }
    nloc = mine > 0u ? mine : 1u; nx = cnt > 0u ? cnt : 1u;
}
DI void xcd_barrier(const XcdBarrier& b) {
    asm volatile("s_waitcnt vmcnt(0)" ::: "memory");
    __syncthreads();
    if (threadIdx.x == 0) {
        unsigned* bar = b.bar;
        __builtin_amdgcn_s_waitcnt(0);
        unsigned nloc = b.st[0], nx = b.st[1];
        if (nloc == 0u) { xcd_barrier_complete(bar, b.x, nloc, nx); b.st[0] = nloc; b.st[1] = nx; }
        const unsigned old = xb_add(&bar[XB_XSUB(b.x)], 1u);
        const unsigned gen = old / nloc;
        if (old + 1u == (gen + 1u) * nloc) {
            __builtin_amdgcn_fence(__ATOMIC_RELEASE, "agent");
            asm volatile("s_waitcnt vmcnt(0)" ::: "memory");
            const unsigned og = xb_add(&bar[XB_TOP], 1u);
            const unsigned tg = og / nx;
            if (og + 1u == (tg + 1u) * nx) xb_add(&bar[XB_TOPGEN], 1u);
            else XB_SPIN(xb_ld(&bar[XB_TOPGEN]) == tg, bar);
            __builtin_amdgcn_fence(__ATOMIC_ACQUIRE, "agent");
            xb_add(&bar[XB_XGEN(b.x)], 1u);
            asm volatile("s_waitcnt vmcnt(0)" ::: "memory");
        } else {
            XB_SPIN(xb_ld(&bar[XB_XGEN(b.x)]) == gen, bar);
            __builtin_amdgcn_fence(__ATOMIC_ACQUIRE, "agent");
            asm volatile("s_waitcnt vmcnt(0)" ::: "memory");
        }
    }
    __syncthreads();
}

__global__ void __launch_bounds__(NTHR) mega(Params p) {
    extern __shared__ __attribute__((aligned(16))) unsigned char lds_raw[];
    LAS unsigned char* lds = (LAS unsigned char*)lds_raw;
    cg::grid_group grid = cg::this_grid();
    int ph = 0;
#ifndef ONLY
#define ONLY -1
#endif
#ifndef TPROBE
#define TPROBE -1
#endif
#define PHASE(kind, body) do { if ((ONLY < 0 || ONLY == (kind)) && ph >= p.ph_lo && ph < p.ph_hi) { \
        unsigned long long t0_ = 0; if (TPROBE == (kind)) t0_ = __builtin_amdgcn_s_memrealtime(); \
        { unsigned char* ws = WSP(); body; } \
        if (ph + 1 < p.ph_hi) { if (ph == 0) grid.sync(); else xcd_barrier(xbar); } \
        if (TPROBE == (kind)) tprobe += __builtin_amdgcn_s_memrealtime() - t0_; } ++ph; } while (0)
    unsigned long long tprobe = 0;
    {
        volatile LAS unsigned* st = (volatile LAS unsigned*)(lds + LDS_BYTES - 16);
        if (threadIdx.x == 0) { st[0] = 0u; st[1] = 0u; *(LAS unsigned long long*)(lds + LDS_BYTES - 32) = 0ull; }
        __syncthreads();
    }
    XcdBarrier xbar = xcd_barrier_post((unsigned*)(WSP() + OFF_BAR), (volatile LAS unsigned*)(lds + LDS_BYTES - 16));
#ifndef DUP_P0
#define DUP_P0 1
#endif
#pragma unroll 1
    for (int rep = 0; rep < DUP_P0; ++rep) {
    PHASE(0, phase_p0a(p, lds));
    PHASE(1, phase_ln(p, MTOT, true, nullptr, nullptr, true, 0, 0, 1, false));
    }
#ifndef XSYNC
#define XSYNC 0
#endif
#pragma unroll 1
    for (int rep = 0; rep < XSYNC; ++rep) grid.sync();
#pragma unroll 1
    for (int l = 0; l < 2; ++l) {
#pragma unroll 1
        for (int s = 0; s < 3; ++s) {
#define X ((float*)(ws + OFF_X))
#define H ((bf16_t*)(ws + OFF_R1))
#define ACT ((bf16_t*)(ws + OFF_R2))
#define W (ws + OFF_W + (size_t)l * SZ_WL)
#define mod ((const float*)(ws + OFF_MOD) + (size_t)l * 9 * 9216)
            const int Mrows = (l == 1 && s == 2) ? MLAT : MTOT;
            if (s != 1) {
#define wgu ((const bf16_t*)(W + (s == 0 ? WO_GU1 : WO_GU2)))
#define wd ((const bf16_t*)(W + (s == 0 ? WO_D1 : WO_D2)))
#ifndef DUP_GU
#define DUP_GU 1
#endif
#ifndef DUP_MIX
#define DUP_MIX 1
#endif
#pragma unroll 1
                for (int rep = 0; rep < DUP_GU; ++rep)
                PHASE(2, gm::gemm_phase(lds, H, 1024, wgu, 1024, Mrows, 5632, 1024, gm::EpiSwiglu{ACT}));
                const bool last = (l == 1 && s == 2);
                const bool dm = !last;
                const int lm = (s == 0) ? l : l + 1;
                const float* lg = INP(10) + (size_t)(l * 3 + s) * D; const float* lb = INP(11) + (size_t)(l * 3 + s) * D;
#define YD ((bf16_t*)(ws + OFF_R1))
#define er (gm::EpiResid{YD, mod + (s == 0 ? 2 : 8) * 1024, 0.5f})
                PHASE(3, gm::gemm_phase(lds, ACT, DFF, wd, DFF, MLAT, 1024, DFF, er));
                if (Mrows == MTOT) {
                    PHASE(9, { if (obid() < 32) gm::gemm_phase(lds, ACT, DFF, wd, DFF, MCTX, 1024, DFF, er, MLAT / 256, 0, 32);
                               else phase_ln(p, MLAT, false, lg, lb, dm, dm ? lm : 0, s == 0 ? 3 : 0, s == 0 ? 4 : 1, last, 0, 32, (int)gridDim.x - 32, YD, l == 0 && s == 0); });
                    PHASE(1, phase_ln(p, MTOT, false, lg, lb, dm, dm ? lm : 0, s == 0 ? 3 : 0, s == 0 ? 4 : 1, last, MLAT, 0, 0, YD, l == 0 && s == 0));
                } else {
                    PHASE(1, phase_ln(p, MLAT, false, lg, lb, dm, dm ? lm : 0, s == 0 ? 3 : 0, s == 0 ? 4 : 1, last, 0, 0, 0, YD, l == 0 && s == 0));
                }
            } else {
#ifndef DUP_WP
#define DUP_WP 1
#endif
#pragma unroll 1
                for (int rep = 0; rep < DUP_WP; ++rep) {
                PHASE(4, gm::gemm_phase(lds, H, 1024, (const bf16_t*)(W + WO_IN), 1024, MTOT, 2048, 1024,
                                     gm::EpiWin{(bf16_t*)(ws + OFF_PA), (bf16_t*)(ws + OFF_PBB), (bf16_t*)(ws + OFF_PC)}));
                PHASE(5, phase_post(p, l, lds));
                }
                PHASE(6, gm::gemm_phase(lds, (const bf16_t*)(ws + OFF_R1), 384, (const bf16_t*)(W + WO_UP), 384, MTOT, 1536, 384,
                                     gm::EpiUp{(bf16_t*)(ws + OFF_UPB), 0.10206207261596577f * LOG2E}));
#pragma unroll 1
                for (int rep = 0; rep < DUP_MIX; ++rep)
{                 PHASE(7, phase_mix(p, l, l == 0, lds)); }
                PHASE(10, phase_untranspose(p, l == 0, lds));
                const float* lg = INP(10) + (size_t)(l * 3 + 1) * D; const float* lb = INP(11) + (size_t)(l * 3 + 1) * D;
#undef er
#undef YD
#define YD ((bf16_t*)(ws + OFF_R2))
#define er (gm::EpiResid{YD, mod + 5 * 1024, 1.0f})
#define MIXp ((const bf16_t*)(ws + OFF_R1))
#define wo ((const bf16_t*)(W + WO_OUT))
                PHASE(8, gm::gemm_phase(lds, MIXp, 1024, wo, 1024, MLAT, 1024, 1024, er));
                if (l == 0) {
                    PHASE(9, { if (obid() < 32) gm::gemm_phase(lds, MIXp, 1024, wo, 1024, MCTX, 1024, 1024, er, MLAT / 256, 0, 32);
                               else phase_ln(p, MLAT, false, lg, lb, true, l, 6, 7, false, 0, 32, (int)gridDim.x - 32, YD); });
                    PHASE(1, phase_ln(p, MTOT, false, lg, lb, true, l, 6, 7, false, MLAT, 0, 0, YD));
                } else {
                    PHASE(1, phase_ln(p, MLAT, false, lg, lb, true, l, 6, 7, false, 0, 0, 0, YD));
                }
            }
        }
    }
    if (HYPROBE || PPROBE) tprobe = *(LAS unsigned long long*)(lds + LDS_BYTES - 32);
    if (TPROBE >= 0 || HYPROBE || PPROBE) {
        xcd_barrier(xbar);
        if (obid() == 0) {
            const unsigned m = (unsigned)(tprobe / 10ull);
            for (unsigned i = threadIdx.x; i < m && i < 200000u; i += NTHR) OUTP()[(size_t)i * 131u] += 0.1f;
        }
    }
}

constexpr int NPHASES = 1 << 20;

extern "C" void kernel_launch(void* const* d_in, const int* in_sizes, int n_in, void* d_out, int out_size, void* d_ws, size_t ws_size, hipStream_t stream) {
    static int grid = 0;
    if (grid == 0) {
        if (n_in != 31 || ws_size < WS_END) { fprintf(stderr, "kernel_launch: unexpected n_in %d or ws_size %zu (< %zu)\n", n_in, ws_size, (size_t)WS_END); grid = -1; return; }
        int dev = 0, cus = 0, per_cu = 0;
        hipGetDevice(&dev);
        hipDeviceGetAttribute(&cus, hipDeviceAttributeMultiprocessorCount, dev);
        if (hipFuncSetAttribute((const void*)mega, hipFuncAttributeMaxDynamicSharedMemorySize, LDS_BYTES) != hipSuccess) { fprintf(stderr, "kernel_launch: hipFuncSetAttribute failed\n"); grid = -1; return; }
        if (hipOccupancyMaxActiveBlocksPerMultiprocessor(&per_cu, (const void*)mega, NTHR, LDS_BYTES) != hipSuccess || per_cu < 1) { fprintf(stderr, "kernel_launch: occupancy query failed (%d)\n", per_cu); per_cu = 1; }
        (void)hipGetLastError();
        grid = cus * (per_cu > 1 ? 1 : per_cu);
    }
    if (grid < 0) return;
    Params prm{};
    for (int i = 0; i < 31; ++i) prm.in[i] = (const float*)d_in[i];
    prm.out = (float*)d_out; prm.ws = (unsigned char*)d_ws;
    prm.ph_lo = 0; prm.ph_hi = NPHASES;
    (void)hipMemsetAsync((unsigned char*)d_ws + OFF_BAR, 0, 4096 * 4, stream);
    void* args[] = {&prm};
    hipError_t e = hipLaunchCooperativeKernel((const void*)mega, dim3(grid), dim3(NTHR), args, LDS_BYTES, stream);
    if (e != hipSuccess) fprintf(stderr, "kernel_launch: cooperative launch failed: %s (grid %d)\n", hipGetErrorString(e), grid);
}
```
